# Optimizing an MI355X kernel written in HIP

```python
import math
import jax, jax.numpy as jnp
from jax import lax
import numpy as np

D_MODEL = 1024
BATCH = 8
SEQ = 4096
DEPTH = 1

PLE_DIM = 256
MLA_HEADS = 8
QK_NOPE_DIM = 64
QK_ROPE_DIM = 32
V_HEAD_DIM = 64
Q_LORA_RANK = 384
KV_LORA_RANK = 256
ROPE_THETA = 10000.0
Q_BLOCK = 128
SSM_WIDTH = D_MODEL // 2
SSM_GROUP = 16
SSM_GROUPS = SSM_WIDTH // SSM_GROUP
SSM_STATE = 64
DT_MIN = 1e-3
DT_MAX = 1e-1
D_FF = 4 * D_MODEL
LN_EPS = 1e-5
RMS_EPS = 1e-6
DEEPNORM_ALPHA = (2.0 * DEPTH) ** 0.25
DEEPNORM_BETA = (8.0 * DEPTH) ** -0.25
IN_SPLITS = (Q_LORA_RANK, KV_LORA_RANK, QK_ROPE_DIM, SSM_WIDTH, D_MODEL, D_MODEL)
IN_WIDTH = sum(IN_SPLITS)

kernel_name = "hybrid_mla_s5_gated_deepnorm_block"


def layer_norm(x, g, b):
    xf = x.astype(jnp.float32)
    mu = jnp.mean(xf, axis=-1, keepdims=True)
    xc = xf - mu
    var = jnp.mean(xc * xc, axis=-1, keepdims=True)
    y = xc * lax.rsqrt(var + LN_EPS) * g.astype(jnp.float32) + b.astype(jnp.float32)
    return y.astype(x.dtype)


def rms_norm(x, g):
    xf = x.astype(jnp.float32)
    y = xf * lax.rsqrt(jnp.mean(xf * xf, axis=-1, keepdims=True) + RMS_EPS) * g.astype(jnp.float32)
    return y.astype(x.dtype)


def rope_tables(positions, dim):
    inv_freq = ROPE_THETA ** (-jnp.arange(0, dim, 2, dtype=jnp.float32) / dim)
    ang = positions.astype(jnp.float32)[..., None] * inv_freq
    return jnp.cos(ang), jnp.sin(ang)


def apply_rope(x, cos, sin):
    xf = x.astype(jnp.float32)
    half = xf.shape[-1] // 2
    x1, x2 = xf[..., :half], xf[..., half:]
    out = jnp.concatenate([x1 * cos - x2 * sin, x2 * cos + x1 * sin], axis=-1)
    return out.astype(x.dtype)


def split_cols(t, sizes):
    outs, start = [], 0
    for s in sizes:
        outs.append(t[..., start:start + s])
        start += s
    return outs


def mla_attention(cq_raw, ckv_raw, k_rope_raw, positions, q_norm_g, w_uq, kv_norm_g, w_ukv):
    bsz, seq, _ = cq_raw.shape
    cq = rms_norm(cq_raw, q_norm_g)
    q = (cq @ w_uq).reshape(bsz, seq, MLA_HEADS, QK_NOPE_DIM + QK_ROPE_DIM)
    q_nope, q_rope = q[..., :QK_NOPE_DIM], q[..., QK_NOPE_DIM:]
    ckv = rms_norm(ckv_raw, kv_norm_g)
    kv = (ckv @ w_ukv).reshape(bsz, seq, MLA_HEADS, QK_NOPE_DIM + V_HEAD_DIM)
    k_nope, v = kv[..., :QK_NOPE_DIM], kv[..., QK_NOPE_DIM:]
    cos, sin = rope_tables(positions, QK_ROPE_DIM)
    q_rope = apply_rope(q_rope, cos[:, :, None, :], sin[:, :, None, :])
    k_rope = apply_rope(k_rope_raw, cos, sin)
    scale = (QK_NOPE_DIM + QK_ROPE_DIM) ** -0.5
    nblk = seq // Q_BLOCK
    qn_blocks = q_nope.reshape(bsz, nblk, Q_BLOCK, MLA_HEADS, QK_NOPE_DIM).transpose(1, 0, 2, 3, 4)
    qr_blocks = q_rope.reshape(bsz, nblk, Q_BLOCK, MLA_HEADS, QK_ROPE_DIM).transpose(1, 0, 2, 3, 4)
    key_idx = jnp.arange(seq)

    def one_block(args):
        blk, qn, qr = args
        s = (jnp.einsum('bqhd,bkhd->bhqk', qn, k_nope)
             + jnp.einsum('bqhr,bkr->bhqk', qr, k_rope)).astype(jnp.float32) * scale
        q_idx = blk * Q_BLOCK + jnp.arange(Q_BLOCK)
        causal = key_idx[None, :] <= q_idx[:, None]
        s = jnp.where(causal[None, None], s, -1e30)
        probs = jax.nn.softmax(s, axis=-1).astype(v.dtype)
        return jnp.einsum('bhqk,bkhd->bqhd', probs, v)

    out = lax.map(one_block, (jnp.arange(nblk), qn_blocks, qr_blocks))
    return out.transpose(1, 0, 2, 3, 4).reshape(bsz, seq, MLA_HEADS * V_HEAD_DIM)


def s5_ssm(u, a_re, a_im, log_dt, b_re, b_im, c_re, c_im, d_skip):
    bsz, seq, _ = u.shape
    f32 = jnp.float32
    uf = u.astype(f32).reshape(bsz, seq, SSM_GROUPS, SSM_GROUP)
    dt = jnp.exp(log_dt.astype(f32))[:, None]
    lam_re = jnp.minimum(a_re.astype(f32), -1e-4)
    lam_im = a_im.astype(f32)
    mag = jnp.exp(lam_re * dt)
    ang = lam_im * dt
    abar_re = mag * jnp.cos(ang)
    abar_im = mag * jnp.sin(ang)
    den = lam_re * lam_re + lam_im * lam_im
    nr = abar_re - 1.0
    ni = abar_im
    f_re = (nr * lam_re + ni * lam_im) / den
    f_im = (ni * lam_re - nr * lam_im) / den
    br = b_re.astype(f32)
    bi = b_im.astype(f32)
    bbar_re = f_re[..., None] * br - f_im[..., None] * bi
    bbar_im = f_re[..., None] * bi + f_im[..., None] * br
    bu_re = jnp.einsum('bsgn,gpn->bsgp', uf, bbar_re)
    bu_im = jnp.einsum('bsgn,gpn->bsgp', uf, bbar_im)
    full = (bsz, seq, SSM_GROUPS, SSM_STATE)
    ar_seq = jnp.broadcast_to(abar_re[None, None], full)
    ai_seq = jnp.broadcast_to(abar_im[None, None], full)

    def combine(left, right):
        ar1, ai1, xr1, xi1 = left
        ar2, ai2, xr2, xi2 = right
        return (ar2 * ar1 - ai2 * ai1,
                ar2 * ai1 + ai2 * ar1,
                ar2 * xr1 - ai2 * xi1 + xr2,
                ar2 * xi1 + ai2 * xr1 + xi2)

    _, _, x_re, x_im = lax.associative_scan(combine, (ar_seq, ai_seq, bu_re, bu_im), axis=1)
    y = (jnp.einsum('bsgp,gnp->bsgn', x_re, c_re.astype(f32))
         - jnp.einsum('bsgp,gnp->bsgn', x_im, c_im.astype(f32)))
    y = y + d_skip.astype(f32).reshape(SSM_GROUPS, SSM_GROUP) * uf
    return y.reshape(bsz, seq, SSM_WIDTH).astype(u.dtype)


def setup_inputs(seed: int = 0) -> dict:
    key = jax.random.key(seed)
    ks = iter(jax.random.split(key, 40))
    f32 = jnp.float32
    L = DEPTH

    def w(shape, fan_in, scale=1.0):
        return jax.random.normal(next(ks), shape, f32) * (fan_in ** -0.5) * scale

    def gain(shape):
        return 1.0 + 0.02 * jax.random.normal(next(ks), shape, f32)

    def bias(shape):
        return 0.02 * jax.random.normal(next(ks), shape, f32)

    x = jax.random.normal(next(ks), (BATCH, SEQ, D_MODEL), f32)
    p = jax.random.normal(next(ks), (DEPTH, BATCH, SEQ, PLE_DIM), f32)
    start = jax.random.randint(next(ks), (BATCH, 1), 0, SEQ, dtype=jnp.int32)
    positions = start + jnp.arange(SEQ, dtype=jnp.int32)[None, :]

    n_idx = jnp.arange(SSM_STATE, dtype=f32)
    a_re = -0.5 + 0.01 * jax.random.normal(next(ks), (L, SSM_GROUPS, SSM_STATE), f32)
    a_im = math.pi * n_idx[None, None, :] + 0.01 * jax.random.normal(next(ks), (L, SSM_GROUPS, SSM_STATE), f32)
    log_dt = jax.random.uniform(next(ks), (L, SSM_GROUPS), f32, math.log(DT_MIN), math.log(DT_MAX))

    return {
        "x": x,
        "p": p,
        "positions": positions,
        "ln_in_g": gain((D_MODEL,)),
        "ln_in_b": bias((D_MODEL,)),
        "w_in": w((L, D_MODEL, IN_WIDTH), D_MODEL),
        "b_gate": bias((L, 2 * D_MODEL)),
        "q_norm_g": gain((L, Q_LORA_RANK)),
        "w_uq": w((L, Q_LORA_RANK, MLA_HEADS * (QK_NOPE_DIM + QK_ROPE_DIM)), Q_LORA_RANK),
        "kv_norm_g": gain((L, KV_LORA_RANK)),
        "w_ukv": w((L, KV_LORA_RANK, MLA_HEADS * (QK_NOPE_DIM + V_HEAD_DIM)), KV_LORA_RANK),
        "w_attn_br": w((L, MLA_HEADS * V_HEAD_DIM, D_MODEL), MLA_HEADS * V_HEAD_DIM),
        "a_re": a_re,
        "a_im": a_im,
        "log_dt": log_dt,
        "b_re": w((L, SSM_GROUPS, SSM_STATE, SSM_GROUP), 2 * SSM_GROUP),
        "b_im": w((L, SSM_GROUPS, SSM_STATE, SSM_GROUP), 2 * SSM_GROUP),
        "c_re": w((L, SSM_GROUPS, SSM_GROUP, SSM_STATE), 2 * SSM_STATE),
        "c_im": w((L, SSM_GROUPS, SSM_GROUP, SSM_STATE), 2 * SSM_STATE),
        "d_skip": jax.random.normal(next(ks), (L, SSM_WIDTH), f32),
        "w_glu": w((L, SSM_WIDTH, SSM_WIDTH), SSM_WIDTH),
        "b_glu": bias((L, SSM_WIDTH)),
        "w_ssm_br": w((L, SSM_WIDTH, D_MODEL), SSM_WIDTH),
        "w_o": w((L, D_MODEL, D_MODEL), D_MODEL, DEEPNORM_BETA),
        "ln1_g": gain((L, D_MODEL)),
        "ln1_b": bias((L, D_MODEL)),
        "w_up": w((L, D_MODEL, D_FF), D_MODEL),
        "w_down": w((L, D_FF, D_MODEL), D_FF, DEEPNORM_BETA),
        "ln2_g": gain((L, D_MODEL)),
        "ln2_b": bias((L, D_MODEL)),
        "w_ple_gate": w((L, D_MODEL, D_MODEL), D_MODEL),
        "b_ple_gate": bias((L, D_MODEL)),
        "w_ple": w((L, PLE_DIM, D_MODEL), PLE_DIM, DEEPNORM_BETA),
        "ln3_g": gain((L, D_MODEL)),
        "ln3_b": bias((L, D_MODEL)),
    }


def reference(x, p, positions, ln_in_g, ln_in_b, w_in, b_gate, q_norm_g, w_uq, kv_norm_g, w_ukv,
              w_attn_br, a_re, a_im, log_dt, b_re, b_im, c_re, c_im, d_skip, w_glu, b_glu,
              w_ssm_br, w_o, ln1_g, ln1_b, w_up, w_down, ln2_g, ln2_b, w_ple_gate, b_ple_gate,
              w_ple, ln3_g, ln3_b):
    h = layer_norm(x, ln_in_g, ln_in_b)
    for l in range(DEPTH):
        proj = h @ w_in[l]
        cq, ckv, kr, u, g_a, g_b = split_cols(proj, IN_SPLITS)
        attn = mla_attention(cq, ckv, kr, positions, q_norm_g[l], w_uq[l], kv_norm_g[l], w_ukv[l])
        branch_a = attn @ w_attn_br[l]
        y = s5_ssm(u, a_re[l], a_im[l], log_dt[l], b_re[l], b_im[l], c_re[l], c_im[l], d_skip[l])
        y = jax.nn.gelu(y)
        y = y * jax.nn.sigmoid(y @ w_glu[l] + b_glu[l])
        branch_b = y @ w_ssm_br[l]
        bg = b_gate[l]
        merged = (jax.nn.sigmoid(g_a + bg[:D_MODEL]) * branch_a
                  + jax.nn.sigmoid(g_b + bg[D_MODEL:]) * branch_b)
        h = layer_norm(DEEPNORM_ALPHA * h + merged @ w_o[l], ln1_g[l], ln1_b[l])
        ff = jnp.square(jax.nn.relu(h @ w_up[l])) @ w_down[l]
        h = layer_norm(DEEPNORM_ALPHA * h + ff, ln2_g[l], ln2_b[l])
        ple = jax.nn.sigmoid(h @ w_ple_gate[l] + b_ple_gate[l]) * (p[l] @ w_ple[l])
        h = layer_norm(DEEPNORM_ALPHA * h + ple, ln3_g[l], ln3_b[l])
    return h
```

```cpp
#include <hip/hip_runtime.h>
#include <cstdio>
#include <cstdint>

typedef unsigned short bf16_t;

constexpr int NB = 8, SEQ = 4096, DM = 1024, M = NB * SEQ;
constexpr int PLE = 256, NH = 8, NOPE = 64, ROPE = 32, VD = 64, QHD = NOPE + ROPE, QL = 384, KVL = 256;
constexpr int SW = 512, SG = 16, NG = 32, SP = 64, DFF = 4096;
constexpr int INW = QL + KVL + ROPE + SW + DM + DM;
constexpr int OFF_CQ = 0, OFF_CKV = QL, OFF_KR = QL + KVL, OFF_U = OFF_KR + ROPE, OFF_GA = OFF_U + SW, OFF_GB = OFF_GA + DM;
constexpr float LN_EPS = 1e-5f, RMS_EPS = 1e-6f;
constexpr float ALPHA = 1.189207115002721f;
constexpr float QSCALE = 0.10206207261596575f * 1.4426950408889634f;

constexpr size_t MiB = 1u << 20;
constexpr size_t WS_CTL = 0;
constexpr size_t WS_ST0 = 34 * MiB;
constexpr size_t WS_RS = WS_ST0 + 512 * 1024;
constexpr size_t WS_ROPE = 37 * MiB;
constexpr size_t WS_PB = 50 * MiB;
constexpr size_t WS_XN = 66 * MiB;
constexpr size_t WS_Q = WS_XN;
constexpr size_t WS_KN = 130 * MiB, WS_V = 162 * MiB;
constexpr size_t WS_PP = 130 * MiB;
constexpr size_t WS_FF = 194 * MiB;
constexpr size_t WS_GA = 194 * MiB, WS_GB = 258 * MiB;
constexpr size_t WS_MG = WS_GA;
constexpr size_t WS_AY = 322 * MiB;
constexpr size_t WS_U2 = 386 * MiB;
constexpr size_t WS_YG = 418 * MiB;
constexpr size_t WS_CQ = 450 * MiB;
constexpr size_t WS_CKV = 482 * MiB;
constexpr size_t WS_KRRAW = 498 * MiB;
constexpr size_t WS_END = 502 * MiB;

__device__ __forceinline__ float bf2f(unsigned v) { return __uint_as_float(v << 16); }
__device__ __forceinline__ bf16_t f2bf(float f) { unsigned u = __float_as_uint(f); return (bf16_t)((u + 0x7fffu + ((u >> 16) & 1u)) >> 16); }
__device__ __forceinline__ float sigmoidf_(float v) { return 1.0f / (1.0f + __expf(-v)); }
__device__ __forceinline__ float gelu_tanh(float v) { const float z = 0.7978845608028654f * (v + 0.044715f * v * v * v); const float e = __expf(2.0f * z); return 0.5f * v * (2.0f - 2.0f / (1.0f + e)); }
__device__ __forceinline__ void sincos_d(double a, double& s, double& c) {
    const double k = __builtin_rint(a * 0.6366197723675814);
    double r = __builtin_fma(-k, 1.5707963267948966, a); r = __builtin_fma(-k, 6.123233995736766e-17, r);
    const double r2 = r * r;
    double sp = -7.647163731819816e-13; sp = sp * r2 + 1.6059043836821613e-10; sp = sp * r2 - 2.505210838544172e-08; sp = sp * r2 + 2.7557319223985893e-06;
    sp = sp * r2 - 0.0001984126984126984; sp = sp * r2 + 0.008333333333333333; sp = sp * r2 - 0.16666666666666666; sp = r + r * r2 * sp;
    double cp = 4.779477332387385e-14; cp = cp * r2 - 1.1470745597729725e-11; cp = cp * r2 + 2.08767569878681e-09; cp = cp * r2 - 2.755731922398589e-07;
    cp = cp * r2 + 2.48015873015873e-05; cp = cp * r2 - 0.001388888888888889; cp = cp * r2 + 0.041666666666666664; cp = cp * r2 - 0.5; cp = 1.0 + r2 * cp;
    const int q = ((int)k) & 3;
    s = (q == 0) ? sp : (q == 1) ? cp : (q == 2) ? -sp : -cp;
    c = (q == 0) ? cp : (q == 1) ? -sp : (q == 2) ? -cp : sp;
}
__device__ __forceinline__ double exp_small_d(double x) {
    double p = 1.0 / 3628800.0; p = p * x + 1.0 / 362880.0; p = p * x + 1.0 / 40320.0; p = p * x + 1.0 / 5040.0; p = p * x + 1.0 / 720.0; p = p * x + 1.0 / 120.0;
    p = p * x + 1.0 / 24.0; p = p * x + 1.0 / 6.0; p = p * x + 0.5; p = p * x + 1.0; p = p * x + 1.0; return p;
}
__constant__ float c_inv_freq[16] = {1.0f, 0.5623413251903491f, 0.31622776601683794f, 0.1778279410038923f, 0.1f, 0.05623413251903491f, 0.03162277660168379f, 0.01778279410038923f,
                                     0.01f, 0.005623413251903491f, 0.003162277660168379f, 0.001778279410038923f, 0.001f, 0.0005623413251903491f, 0.00031622776601683794f, 0.0001778279410038923f};

__global__ void __launch_bounds__(256) k_ln(const float* in, float* out_f, bf16_t* out_b, float* stats, const float* __restrict__ g, const float* __restrict__ b) {
    const int lane = threadIdx.x & 63, row = blockIdx.x * 4 + (threadIdx.x >> 6);
    const float4* xr = (const float4*)(in + (size_t)row * DM) + lane;
    float4 v[4]; float s = 0.f;
#pragma unroll
    for (int j = 0; j < 4; ++j) { v[j] = xr[64 * j]; s += (v[j].x + v[j].y) + (v[j].z + v[j].w); }
#pragma unroll
    for (int o = 1; o < 64; o <<= 1) s += __shfl_xor(s, o);
    const float mean = s * (1.f / DM); float s2 = 0.f;
#pragma unroll
    for (int j = 0; j < 4; ++j) { v[j].x -= mean; v[j].y -= mean; v[j].z -= mean; v[j].w -= mean; s2 += (v[j].x * v[j].x + v[j].y * v[j].y) + (v[j].z * v[j].z + v[j].w * v[j].w); }
#pragma unroll
    for (int o = 1; o < 64; o <<= 1) s2 += __shfl_xor(s2, o);
    const float rstd = 1.0f / sqrtf(s2 * (1.f / DM) + LN_EPS);
    if (stats && lane == 0) { stats[2 * row] = mean; stats[2 * row + 1] = rstd; }
#pragma unroll
    for (int j = 0; j < 4; ++j) {
        const float4 gg = ((const float4*)g)[lane + 64 * j], bb = ((const float4*)b)[lane + 64 * j];
        float4 o; o.x = v[j].x * rstd * gg.x + bb.x; o.y = v[j].y * rstd * gg.y + bb.y; o.z = v[j].z * rstd * gg.z + bb.z; o.w = v[j].w * rstd * gg.w + bb.w;
        if (out_f) ((float4*)(out_f + (size_t)row * DM))[lane + 64 * j] = o;
        if (out_b) { uint2 w; w.x = (unsigned)f2bf(o.x) | ((unsigned)f2bf(o.y) << 16); w.y = (unsigned)f2bf(o.z) | ((unsigned)f2bf(o.w) << 16); ((uint2*)(out_b + (size_t)row * DM))[lane + 64 * j] = w; }
    }
}
__global__ void __launch_bounds__(256) k_to_bf16(const float* __restrict__ in, bf16_t* __restrict__ out, size_t n4) {
    for (size_t i = (size_t)blockIdx.x * 256 + threadIdx.x; i < n4; i += (size_t)gridDim.x * 256) {
        const float4 v = ((const float4*)in)[i]; uint2 w; w.x = (unsigned)f2bf(v.x) | ((unsigned)f2bf(v.y) << 16); w.y = (unsigned)f2bf(v.z) | ((unsigned)f2bf(v.w) << 16); ((uint2*)out)[i] = w; }
}
__global__ void __launch_bounds__(256) k_rope_tab(const int* __restrict__ pos, float2* __restrict__ tab) {
    const int idx = blockIdx.x * 256 + threadIdx.x; if (idx >= M * 16) return;
    const int r = idx >> 4, i = idx & 15;
    const float ang = (float)pos[r] * c_inv_freq[i];
    double s, c; sincos_d((double)ang, s, c);
    tab[idx] = make_float2((float)c, (float)s);
}
__global__ void __launch_bounds__(256) k_rms_stats(const bf16_t* __restrict__ CQ, const bf16_t* __restrict__ CKV, float* __restrict__ RS) {
    const int lane = threadIdx.x & 63, row = blockIdx.x * 4 + (threadIdx.x >> 6);
    float sq = 0.f, sk = 0.f;
    for (int c = lane; c < QL; c += 64) { const float v = bf2f(CQ[(size_t)row * 512 + c]); sq += v * v; }
    for (int c = lane; c < KVL; c += 64) { const float v = bf2f(CKV[(size_t)row * 256 + c]); sk += v * v; }
#pragma unroll
    for (int o = 1; o < 64; o <<= 1) { sq += __shfl_xor(sq, o); sk += __shfl_xor(sk, o); }
    if (lane == 0) { RS[2 * row] = 1.0f / sqrtf(sq * (1.f / QL) + RMS_EPS); RS[2 * row + 1] = 1.0f / sqrtf(sk * (1.f / KVL) + RMS_EPS); }
}
__global__ void __launch_bounds__(256) k_rope_k(const float* __restrict__ KR, const float2* __restrict__ tab, bf16_t* __restrict__ CQ) {
    const int idx = blockIdx.x * 256 + threadIdx.x; if (idx >= M * 32) return;
    const int r = idx >> 5, c = idx & 31, i = c & 15; const float2 cs = tab[r * 16 + i];
    const float x1 = KR[r * 32 + i], x2 = KR[r * 32 + 16 + i];
    const float o = (c < 16) ? (x1 * cs.x - x2 * cs.y) : (x2 * cs.x + x1 * cs.y);
    CQ[(size_t)r * 512 + QL + c] = f2bf(o);
}
__global__ void __launch_bounds__(256) k_rope_q(const float* __restrict__ Qraw, const float2* __restrict__ tab, bf16_t* __restrict__ Q) {
    const size_t idx = (size_t)blockIdx.x * 256 + threadIdx.x; if (idx >= (size_t)M * 768) return;
    const int r = (int)(idx / 768), c = (int)(idx % 768), d = c % QHD;
    float o;
    if (d < NOPE) o = Qraw[idx];
    else { const int j = d - NOPE, i = j & 15; const float2 cs = tab[r * 16 + i];
        const size_t b0 = idx - j; const float x1 = Qraw[b0 + i], x2 = Qraw[b0 + 16 + i];
        o = (j < 16) ? (x1 * cs.x - x2 * cs.y) : (x2 * cs.x + x1 * cs.y); }
    Q[idx] = f2bf(o * QSCALE);
}

template <class Epi>
__global__ void __launch_bounds__(256) ref_gemm(const bf16_t* __restrict__ A, int lda, const float* __restrict__ W, int ldw, const float* __restrict__ wscale, int N, int K, Epi epi) {
    __shared__ float As[16][68];
    __shared__ float Ws[16][68];
    const int tid = threadIdx.x, tx = tid & 15, ty = tid >> 4;
    const int m0 = blockIdx.y * 64, n0 = blockIdx.x * 64;
    float acc[4][4];
#pragma unroll
    for (int i = 0; i < 4; ++i)
#pragma unroll
        for (int j = 0; j < 4; ++j) acc[i][j] = 0.f;
    for (int k0 = 0; k0 < K; k0 += 16) {
        { const int r = tid >> 2, kk = (tid & 3) * 4; const uint2 v = *(const uint2*)(A + (size_t)(m0 + r) * lda + k0 + kk);
          As[kk + 0][r] = bf2f(v.x & 0xffffu); As[kk + 1][r] = bf2f(v.x >> 16); As[kk + 2][r] = bf2f(v.y & 0xffffu); As[kk + 3][r] = bf2f(v.y >> 16); }
        { const int kk = tid >> 4, nn = (tid & 15) * 4; const float sc = wscale ? wscale[k0 + kk] : 1.f;
#pragma unroll
          for (int j = 0; j < 4; ++j) { const int n = n0 + nn + j; const float w = (n < N) ? W[(size_t)(k0 + kk) * ldw + n] * sc : 0.f; Ws[kk][nn + j] = bf2f((unsigned)f2bf(w)); } }
        __syncthreads();
#pragma unroll
        for (int kk = 0; kk < 16; ++kk) {
            const float4 a = *(const float4*)&As[kk][ty * 4]; const float4 b = *(const float4*)&Ws[kk][tx * 4];
            acc[0][0] += a.x * b.x; acc[0][1] += a.x * b.y; acc[0][2] += a.x * b.z; acc[0][3] += a.x * b.w;
            acc[1][0] += a.y * b.x; acc[1][1] += a.y * b.y; acc[1][2] += a.y * b.z; acc[1][3] += a.y * b.w;
            acc[2][0] += a.z * b.x; acc[2][1] += a.z * b.y; acc[2][2] += a.z * b.z; acc[2][3] += a.z * b.w;
            acc[3][0] += a.w * b.x; acc[3][1] += a.w * b.y; acc[3][2] += a.w * b.z; acc[3][3] += a.w * b.w;
        }
        __syncthreads();
    }
#pragma unroll
    for (int i = 0; i < 4; ++i)
#pragma unroll
        for (int j = 0; j < 4; ++j) { const int row = m0 + ty * 4 + i, col = n0 + tx * 4 + j; if (col < N) epi(row, col, acc[i][j]); }
}
struct EpiCq { bf16_t* CQ; __device__ void operator()(int r, int c, float v) const { CQ[(size_t)r * 512 + c] = f2bf(v); } };
struct EpiCkv { bf16_t* CKV; __device__ void operator()(int r, int c, float v) const { CKV[(size_t)r * 256 + c] = f2bf(v); } };
struct EpiKr { float* KR; __device__ void operator()(int r, int c, float v) const { KR[(size_t)r * 32 + c] = v; } };
struct EpiU { bf16_t* U2; __device__ void operator()(int r, int c, float v) const { const int b = r / SEQ, t = r % SEQ, g = c >> 4, n = c & 15; U2[(((size_t)b * NG + g) * SEQ + t) * 16 + n] = f2bf(v); } };
struct EpiGate { bf16_t* G; const float* bias; __device__ void operator()(int r, int c, float v) const { G[(size_t)r * DM + c] = f2bf(sigmoidf_(v + bias[c])); } };
struct EpiQraw { float* Qraw; const float* RS; __device__ void operator()(int r, int c, float v) const { Qraw[(size_t)r * 768 + c] = v * RS[2 * r]; } };
struct EpiKv { bf16_t* KN; bf16_t* V; const float* RS; __device__ void operator()(int r, int c, float v) const { v *= RS[2 * r + 1]; const int h = c >> 7, d = c & 127;
    if (d < 64) KN[(size_t)r * 512 + 64 * h + d] = f2bf(v); else V[(size_t)r * 512 + 64 * h + d - 64] = f2bf(v); } };
struct EpiGlu { const bf16_t* YG; bf16_t* AY; const float* b; __device__ void operator()(int r, int c, float v) const { const float y = bf2f(YG[(size_t)r * 512 + c]); AY[(size_t)r * DM + 512 + c] = f2bf(y * sigmoidf_(v + b[c])); } };
struct EpiPP { bf16_t* PP; __device__ void operator()(int r, int c, float v) const { PP[(size_t)r * DM + c] = f2bf(v); } };
struct EpiBrA { const bf16_t* GA; float* T1; __device__ void operator()(int r, int c, float v) const { T1[(size_t)r * DM + c] = bf2f(GA[(size_t)r * DM + c]) * v; } };
struct EpiBrB { const bf16_t* GB; const float* T1; bf16_t* MG; __device__ void operator()(int r, int c, float v) const { MG[(size_t)r * DM + c] = f2bf(T1[(size_t)r * DM + c] + bf2f(GB[(size_t)r * DM + c]) * v); } };
struct EpiWo { const float* x; const float* ST0; const float* g; const float* b; float* out;
    __device__ void operator()(int r, int c, float v) const { const float h0 = (x[(size_t)r * DM + c] - ST0[2 * r]) * ST0[2 * r + 1] * g[c] + b[c]; out[(size_t)r * DM + c] = ALPHA * h0 + v; } };
struct EpiUp { bf16_t* FF; __device__ void operator()(int r, int c, float v) const { const float t = fmaxf(v, 0.f); FF[(size_t)r * DFF + c] = f2bf(t * t); } };
struct EpiDown { float* out; __device__ void operator()(int r, int c, float v) const { out[(size_t)r * DM + c] = ALPHA * out[(size_t)r * DM + c] + v; } };
struct EpiPle { float* out; const bf16_t* PP; const float* b; __device__ void operator()(int r, int c, float v) const { out[(size_t)r * DM + c] = ALPHA * out[(size_t)r * DM + c] + sigmoidf_(v + b[c]) * bf2f(PP[(size_t)r * DM + c]); } };

__global__ void __launch_bounds__(64) ref_attn(const bf16_t* __restrict__ Q, const bf16_t* __restrict__ KN, const bf16_t* __restrict__ CQ, const bf16_t* __restrict__ V, bf16_t* __restrict__ AY) {
    __shared__ float Ks[64][97];
    __shared__ float Vs[64][65];
    const int qt = blockIdx.x, h = blockIdx.y, b = blockIdx.z, tid = threadIdx.x;
    const size_t qrow = (size_t)b * SEQ + qt * 64 + tid;
    float q[QHD], o[VD];
#pragma unroll
    for (int d = 0; d < QHD; ++d) q[d] = bf2f(Q[qrow * 768 + h * QHD + d]);
#pragma unroll
    for (int d = 0; d < VD; ++d) o[d] = 0.f;
    float m = -1e30f, l = 0.f;
    for (int kt = 0; kt <= qt; ++kt) {
        __syncthreads();
        { const size_t krow = (size_t)b * SEQ + kt * 64 + tid;
          for (int d = 0; d < NOPE; ++d) Ks[tid][d] = bf2f(KN[krow * 512 + h * 64 + d]);
          for (int d = 0; d < ROPE; ++d) Ks[tid][NOPE + d] = bf2f(CQ[krow * 512 + QL + d]);
          for (int d = 0; d < VD; ++d) Vs[tid][d] = bf2f(V[krow * 512 + h * 64 + d]); }
        __syncthreads();
        for (int j = 0; j < 64; ++j) {
            if (kt < qt || j <= tid) {
                float s = 0.f;
#pragma unroll
                for (int d = 0; d < QHD; ++d) s += q[d] * Ks[j][d];
                if (s > m) { const float sc = exp2f(m - s); l *= sc;
#pragma unroll
                    for (int d = 0; d < VD; ++d) o[d] *= sc;
                    m = s; }
                const float p = exp2f(s - m); l += p;
#pragma unroll
                for (int d = 0; d < VD; ++d) o[d] += p * Vs[j][d];
            }
        }
    }
    const float rl = 1.0f / l;
#pragma unroll
    for (int d = 0; d < VD; ++d) AY[qrow * DM + h * VD + d] = f2bf(o[d] * rl);
}

__global__ void __launch_bounds__(64) ref_s5(const bf16_t* __restrict__ U2, const float* __restrict__ a_re, const float* __restrict__ a_im, const float* __restrict__ log_dt,
                                             const float* __restrict__ b_re, const float* __restrict__ b_im, const float* __restrict__ c_re, const float* __restrict__ c_im,
                                             const float* __restrict__ d_skip, bf16_t* __restrict__ YG) {
    __shared__ float us[64][17];
    __shared__ float xs[64][129];
    __shared__ float Cm[128][16];
    const int g = blockIdx.x, b = blockIdx.y, p = threadIdx.x;
    float ar, ai, bbr[16], bbi[16];
    {
        const double dt = (double)__expf(log_dt[g]);
        const double lr = (double)fminf(a_re[g * SP + p], -1e-4f), li = (double)a_im[g * SP + p];
        const double mag = exp_small_d(lr * dt); double sn, cs; sincos_d(li * dt, sn, cs);
        const double abr = mag * cs, abi = mag * sn;
        const double den = lr * lr + li * li, nr = abr - 1.0, ni = abi;
        const double fr = (nr * lr + ni * li) / den, fi = (ni * lr - nr * li) / den;
        ar = (float)abr; ai = (float)abi;
#pragma unroll
        for (int n = 0; n < 16; ++n) { const double br = (double)b_re[((size_t)g * SP + p) * SG + n], bi = (double)b_im[((size_t)g * SP + p) * SG + n];
            bbr[n] = (float)(fr * br - fi * bi); bbi[n] = (float)(fr * bi + fi * br); }
        for (int n = 0; n < 16; ++n) { Cm[p][n] = c_re[((size_t)g * SG + n) * SP + p]; Cm[64 + p][n] = -c_im[((size_t)g * SG + n) * SP + p]; }
    }
    float dsk[16];
#pragma unroll
    for (int n = 0; n < 16; ++n) dsk[n] = d_skip[g * SG + n];
    float xr = 0.f, xi = 0.f;
    const bf16_t* ub = U2 + ((size_t)b * NG + g) * SEQ * 16;
    for (int t0 = 0; t0 < SEQ; t0 += 64) {
        __syncthreads();
        for (int n = 0; n < 16; ++n) us[p][n] = bf2f(ub[(size_t)(t0 + p) * 16 + n]);
        __syncthreads();
        for (int tt = 0; tt < 64; ++tt) {
            float br = 0.f, bi = 0.f;
#pragma unroll
            for (int n = 0; n < 16; ++n) { const float uv = us[tt][n]; br += bbr[n] * uv; bi += bbi[n] * uv; }
            const float nr = ar * xr - ai * xi + br, ni = ar * xi + ai * xr + bi; xr = nr; xi = ni;
            xs[tt][p] = xr; xs[tt][64 + p] = xi;
        }
        __syncthreads();
        float y[16];
#pragma unroll
        for (int n = 0; n < 16; ++n) y[n] = dsk[n] * us[p][n];
        for (int k = 0; k < 128; ++k) { const float xv = xs[p][k];
#pragma unroll
            for (int n = 0; n < 16; ++n) y[n] += xv * Cm[k][n]; }
        bf16_t* yo = YG + ((size_t)b * SEQ + t0 + p) * SW + g * SG;
#pragma unroll
        for (int n = 0; n < 16; ++n) yo[n] = f2bf(gelu_tanh(y[n]));
    }
}

template <class Epi> static void run_gemm(hipStream_t st, const bf16_t* A, int lda, const float* W, int ldw, const float* wscale, int N, int K, Epi e) {
    hipLaunchKernelGGL(ref_gemm<Epi>, dim3((N + 63) / 64, M / 64), dim3(256), 0, st, A, lda, W, ldw, wscale, N, K, e);
}
extern "C" void kernel_launch(void* const* d_in, const int* in_sizes, int n_in, void* d_out, int out_size, void* d_ws, size_t ws_size, hipStream_t stream) {
    if (n_in != 35 || in_sizes[0] != M * DM || out_size != M * DM || ws_size < WS_END) { fprintf(stderr, "kernel_launch: unexpected shapes (n_in %d, in0 %d, out %d, ws %zu)\n", n_in, n_in > 0 ? in_sizes[0] : -1, out_size, ws_size); return; }
    const float* x = (const float*)d_in[0]; const float* p = (const float*)d_in[1]; const int* pos = (const int*)d_in[2];
    const float *ln_in_g = (const float*)d_in[3], *ln_in_b = (const float*)d_in[4], *w_in = (const float*)d_in[5], *b_gate = (const float*)d_in[6], *q_norm_g = (const float*)d_in[7],
                *w_uq = (const float*)d_in[8], *kv_norm_g = (const float*)d_in[9], *w_ukv = (const float*)d_in[10], *w_attn_br = (const float*)d_in[11], *a_re = (const float*)d_in[12],
                *a_im = (const float*)d_in[13], *log_dt = (const float*)d_in[14], *b_re = (const float*)d_in[15], *b_im = (const float*)d_in[16], *c_re = (const float*)d_in[17],
                *c_im = (const float*)d_in[18], *d_skip = (const float*)d_in[19], *w_glu = (const float*)d_in[20], *b_glu = (const float*)d_in[21], *w_ssm_br = (const float*)d_in[22],
                *w_o = (const float*)d_in[23], *ln1_g = (const float*)d_in[24], *ln1_b = (const float*)d_in[25], *w_up = (const float*)d_in[26], *w_down = (const float*)d_in[27],
                *ln2_g = (const float*)d_in[28], *ln2_b = (const float*)d_in[29], *w_pg = (const float*)d_in[30], *b_pg = (const float*)d_in[31], *w_ple = (const float*)d_in[32],
                *ln3_g = (const float*)d_in[33], *ln3_b = (const float*)d_in[34];
    unsigned char* ws = (unsigned char*)d_ws; float* out = (float*)d_out;
    float* ST0 = (float*)(ws + WS_ST0); float* RS = (float*)(ws + WS_RS); float2* RT = (float2*)(ws + WS_ROPE);
    bf16_t *PB = (bf16_t*)(ws + WS_PB), *XN = (bf16_t*)(ws + WS_XN), *Q = (bf16_t*)(ws + WS_Q), *KN = (bf16_t*)(ws + WS_KN), *V = (bf16_t*)(ws + WS_V), *PP = (bf16_t*)(ws + WS_PP),
           *FF = (bf16_t*)(ws + WS_FF), *GA = (bf16_t*)(ws + WS_GA), *GB = (bf16_t*)(ws + WS_GB), *MG = (bf16_t*)(ws + WS_MG), *AY = (bf16_t*)(ws + WS_AY), *U2 = (bf16_t*)(ws + WS_U2),
           *YG = (bf16_t*)(ws + WS_YG), *CQ = (bf16_t*)(ws + WS_CQ), *CKV = (bf16_t*)(ws + WS_CKV);
    float* KRraw = (float*)(ws + WS_KRRAW); float* TMP = out;

    hipLaunchKernelGGL(k_ln, dim3(M / 4), dim3(256), 0, stream, x, (float*)nullptr, XN, ST0, ln_in_g, ln_in_b);
    hipLaunchKernelGGL(k_to_bf16, dim3(2048), dim3(256), 0, stream, p, PB, (size_t)M * PLE / 4);
    hipLaunchKernelGGL(k_rope_tab, dim3(M * 16 / 256), dim3(256), 0, stream, pos, RT);
    run_gemm(stream, XN, DM, w_in + OFF_CQ, INW, nullptr, QL, DM, EpiCq{CQ});
    run_gemm(stream, XN, DM, w_in + OFF_CKV, INW, nullptr, KVL, DM, EpiCkv{CKV});
    run_gemm(stream, XN, DM, w_in + OFF_KR, INW, nullptr, ROPE, DM, EpiKr{KRraw});
    run_gemm(stream, XN, DM, w_in + OFF_U, INW, nullptr, SW, DM, EpiU{U2});
    run_gemm(stream, XN, DM, w_in + OFF_GA, INW, nullptr, DM, DM, EpiGate{GA, b_gate});
    run_gemm(stream, XN, DM, w_in + OFF_GB, INW, nullptr, DM, DM, EpiGate{GB, b_gate + DM});
    hipLaunchKernelGGL(k_rope_k, dim3(M * 32 / 256), dim3(256), 0, stream, KRraw, RT, CQ);
    hipLaunchKernelGGL(k_rms_stats, dim3(M / 4), dim3(256), 0, stream, CQ, CKV, RS);
    run_gemm(stream, CQ, 512, w_uq, NH * QHD, q_norm_g, NH * QHD, QL, EpiQraw{TMP, RS});
    hipLaunchKernelGGL(k_rope_q, dim3((unsigned)(((size_t)M * 768 + 255) / 256)), dim3(256), 0, stream, TMP, RT, Q);
    run_gemm(stream, CKV, 256, w_ukv, NH * 128, kv_norm_g, NH * 128, KVL, EpiKv{KN, V, RS});
    hipLaunchKernelGGL(ref_attn, dim3(SEQ / 64, NH, NB), dim3(64), 0, stream, Q, KN, CQ, V, AY);
    hipLaunchKernelGGL(ref_s5, dim3(NG, NB), dim3(64), 0, stream, U2, a_re, a_im, log_dt, b_re, b_im, c_re, c_im, d_skip, YG);
    run_gemm(stream, YG, SW, w_glu, SW, nullptr, SW, SW, EpiGlu{YG, AY, b_glu});
    run_gemm(stream, PB, PLE, w_ple, DM, nullptr, DM, PLE, EpiPP{PP});
    run_gemm(stream, AY, DM, w_attn_br, DM, nullptr, DM, NH * VD, EpiBrA{GA, TMP});
    run_gemm(stream, AY + 512, DM, w_ssm_br, DM, nullptr, DM, SW, EpiBrB{GB, TMP, MG});
    run_gemm(stream, MG, DM, w_o, DM, nullptr, DM, DM, EpiWo{x, ST0, ln_in_g, ln_in_b, out});
    hipLaunchKernelGGL(k_ln, dim3(M / 4), dim3(256), 0, stream, out, out, XN, (float*)nullptr, ln1_g, ln1_b);
    run_gemm(stream, XN, DM, w_up, DFF, nullptr, DFF, DM, EpiUp{FF});
    run_gemm(stream, FF, DFF, w_down, DM, nullptr, DM, DFF, EpiDown{out});
    hipLaunchKernelGGL(k_ln, dim3(M / 4), dim3(256), 0, stream, out, out, XN, (float*)nullptr, ln2_g, ln2_b);
    run_gemm(stream, XN, DM, w_pg, DM, nullptr, DM, DM, EpiPle{out, PP, b_pg});
    hipLaunchKernelGGL(k_ln, dim3(M / 4), dim3(256), 0, stream, out, out, (bf16_t*)nullptr, (float*)nullptr, ln3_g, ln3_b);
}
```

```cpp
#include <hip/hip_runtime.h>
#include <cstdio>
#include <cstdint>

typedef unsigned short bf16_t;

constexpr int NB = 8, SEQ = 4096, DM = 1024, M = NB * SEQ;
constexpr int PLE = 256, NH = 8, NOPE = 64, ROPE = 32, VD = 64, QHD = NOPE + ROPE, QL = 384, KVL = 256;
constexpr int SW = 512, SG = 16, NG = 32, SP = 64, DFF = 4096;
constexpr int INW = QL + KVL + ROPE + SW + DM + DM;
constexpr int OFF_CQ = 0, OFF_CKV = QL, OFF_KR = QL + KVL, OFF_U = OFF_KR + ROPE, OFF_GA = OFF_U + SW, OFF_GB = OFF_GA + DM;
constexpr float LN_EPS = 1e-5f, RMS_EPS = 1e-6f;
constexpr float ALPHA = 1.189207115002721f;
constexpr float QSCALE = 0.10206207261596575f * 1.4426950408889634f;

constexpr size_t MiB = 1u << 20;
constexpr size_t WS_CTL = 0;
constexpr size_t WS_ST0 = 34 * MiB;
constexpr size_t WS_RS = WS_ST0 + 512 * 1024;
constexpr size_t WS_ROPE = 37 * MiB;
constexpr size_t WS_PB = 50 * MiB;
constexpr size_t WS_XN = 66 * MiB;
constexpr size_t WS_Q = WS_XN;
constexpr size_t WS_KN = 130 * MiB, WS_V = 162 * MiB;
constexpr size_t WS_PP = 130 * MiB;
constexpr size_t WS_FF = 194 * MiB;
constexpr size_t WS_GA = 194 * MiB, WS_GB = 258 * MiB;
constexpr size_t WS_MG = WS_GA;
constexpr size_t WS_AY = 322 * MiB;
constexpr size_t WS_U2 = 386 * MiB;
constexpr size_t WS_YG = 418 * MiB;
constexpr size_t WS_CQ = 450 * MiB;
constexpr size_t WS_CKV = 482 * MiB;
constexpr size_t WS_KRRAW = 498 * MiB;
constexpr size_t WS_END = 502 * MiB;

__device__ __forceinline__ float bf2f(unsigned v) { return __uint_as_float(v << 16); }
__device__ __forceinline__ bf16_t f2bf(float f) { unsigned u = __float_as_uint(f); return (bf16_t)((u + 0x7fffu + ((u >> 16) & 1u)) >> 16); }
__device__ __forceinline__ float sigmoidf_(float v) { return 1.0f / (1.0f + __expf(-v)); }
__device__ __forceinline__ float gelu_tanh(float v) { const float z = 0.7978845608028654f * (v + 0.044715f * v * v * v); const float e = __expf(2.0f * z); return 0.5f * v * (2.0f - 2.0f / (1.0f + e)); }
__device__ __forceinline__ void sincos_d(double a, double& s, double& c) {
    const double k = __builtin_rint(a * 0.6366197723675814);
    double r = __builtin_fma(-k, 1.5707963267948966, a); r = __builtin_fma(-k, 6.123233995736766e-17, r);
    const double r2 = r * r;
    double sp = -7.647163731819816e-13; sp = sp * r2 + 1.6059043836821613e-10; sp = sp * r2 - 2.505210838544172e-08; sp = sp * r2 + 2.7557319223985893e-06;
    sp = sp * r2 - 0.0001984126984126984; sp = sp * r2 + 0.008333333333333333; sp = sp * r2 - 0.16666666666666666; sp = r + r * r2 * sp;
    double cp = 4.779477332387385e-14; cp = cp * r2 - 1.1470745597729725e-11; cp = cp * r2 + 2.08767569878681e-09; cp = cp * r2 - 2.755731922398589e-07;
    cp = cp * r2 + 2.48015873015873e-05; cp = cp * r2 - 0.001388888888888889; cp = cp * r2 + 0.041666666666666664; cp = cp * r2 - 0.5; cp = 1.0 + r2 * cp;
    const int q = ((int)k) & 3;
    s = (q == 0) ? sp : (q == 1) ? cp : (q == 2) ? -sp : -cp;
    c = (q == 0) ? cp : (q == 1) ? -sp : (q == 2) ? -cp : sp;
}
__device__ __forceinline__ double exp_small_d(double x) {
    double p = 1.0 / 3628800.0; p = p * x + 1.0 / 362880.0; p = p * x + 1.0 / 40320.0; p = p * x + 1.0 / 5040.0; p = p * x + 1.0 / 720.0; p = p * x + 1.0 / 120.0;
    p = p * x + 1.0 / 24.0; p = p * x + 1.0 / 6.0; p = p * x + 0.5; p = p * x + 1.0; p = p * x + 1.0; return p;
}
__constant__ float c_inv_freq[16] = {1.0f, 0.5623413251903491f, 0.31622776601683794f, 0.1778279410038923f, 0.1f, 0.05623413251903491f, 0.03162277660168379f, 0.01778279410038923f,
                                     0.01f, 0.005623413251903491f, 0.003162277660168379f, 0.001778279410038923f, 0.001f, 0.0005623413251903491f, 0.00031622776601683794f, 0.0001778279410038923f};

__global__ void __launch_bounds__(256) k_ln(const float* in, float* out_f, bf16_t* out_b, float* stats, const float* __restrict__ g, const float* __restrict__ b) {
    const int lane = threadIdx.x & 63, row = blockIdx.x * 4 + (threadIdx.x >> 6);
    const float4* xr = (const float4*)(in + (size_t)row * DM) + lane;
    float4 v[4]; float s = 0.f;
#pragma unroll
    for (int j = 0; j < 4; ++j) { v[j] = xr[64 * j]; s += (v[j].x + v[j].y) + (v[j].z + v[j].w); }
#pragma unroll
    for (int o = 1; o < 64; o <<= 1) s += __shfl_xor(s, o);
    const float mean = s * (1.f / DM); float s2 = 0.f;
#pragma unroll
    for (int j = 0; j < 4; ++j) { v[j].x -= mean; v[j].y -= mean; v[j].z -= mean; v[j].w -= mean; s2 += (v[j].x * v[j].x + v[j].y * v[j].y) + (v[j].z * v[j].z + v[j].w * v[j].w); }
#pragma unroll
    for (int o = 1; o < 64; o <<= 1) s2 += __shfl_xor(s2, o);
    const float rstd = 1.0f / sqrtf(s2 * (1.f / DM) + LN_EPS);
    if (stats && lane == 0) { stats[2 * row] = mean; stats[2 * row + 1] = rstd; }
#pragma unroll
    for (int j = 0; j < 4; ++j) {
        const float4 gg = ((const float4*)g)[lane + 64 * j], bb = ((const float4*)b)[lane + 64 * j];
        float4 o; o.x = v[j].x * rstd * gg.x + bb.x; o.y = v[j].y * rstd * gg.y + bb.y; o.z = v[j].z * rstd * gg.z + bb.z; o.w = v[j].w * rstd * gg.w + bb.w;
        if (out_f) ((float4*)(out_f + (size_t)row * DM))[lane + 64 * j] = o;
        if (out_b) { uint2 w; w.x = (unsigned)f2bf(o.x) | ((unsigned)f2bf(o.y) << 16); w.y = (unsigned)f2bf(o.z) | ((unsigned)f2bf(o.w) << 16); ((uint2*)(out_b + (size_t)row * DM))[lane + 64 * j] = w; }
    }
}
__global__ void __launch_bounds__(256) k_to_bf16(const float* __restrict__ in, bf16_t* __restrict__ out, size_t n4) {
    for (size_t i = (size_t)blockIdx.x * 256 + threadIdx.x; i < n4; i += (size_t)gridDim.x * 256) {
        const float4 v = ((const float4*)in)[i]; uint2 w; w.x = (unsigned)f2bf(v.x) | ((unsigned)f2bf(v.y) << 16); w.y = (unsigned)f2bf(v.z) | ((unsigned)f2bf(v.w) << 16); ((uint2*)out)[i] = w; }
}
__global__ void __launch_bounds__(256) k_rope_tab(const int* __restrict__ pos, float2* __restrict__ tab) {
    const int idx = blockIdx.x * 256 + threadIdx.x; if (idx >= M * 16) return;
    const int r = idx >> 4, i = idx & 15;
    const float ang = (float)pos[r] * c_inv_freq[i];
    double s, c; sincos_d((double)ang, s, c);
    tab[idx] = make_float2((float)c, (float)s);
}
__global__ void __launch_bounds__(256) k_rms_stats(const bf16_t* __restrict__ CQ, const bf16_t* __restrict__ CKV, float* __restrict__ RS) {
    const int lane = threadIdx.x & 63, row = blockIdx.x * 4 + (threadIdx.x >> 6);
    float sq = 0.f, sk = 0.f;
    for (int c = lane; c < QL; c += 64) { const float v = bf2f(CQ[(size_t)row * 512 + c]); sq += v * v; }
    for (int c = lane; c < KVL; c += 64) { const float v = bf2f(CKV[(size_t)row * 256 + c]); sk += v * v; }
#pragma unroll
    for (int o = 1; o < 64; o <<= 1) { sq += __shfl_xor(sq, o); sk += __shfl_xor(sk, o); }
    if (lane == 0) { RS[2 * row] = 1.0f / sqrtf(sq * (1.f / QL) + RMS_EPS); RS[2 * row + 1] = 1.0f / sqrtf(sk * (1.f / KVL) + RMS_EPS); }
}
__global__ void __launch_bounds__(256) k_rope_k(const float* __restrict__ KR, const float2* __restrict__ tab, bf16_t* __restrict__ CQ) {
    const int idx = blockIdx.x * 256 + threadIdx.x; if (idx >= M * 32) return;
    const int r = idx >> 5, c = idx & 31, i = c & 15; const float2 cs = tab[r * 16 + i];
    const float x1 = KR[r * 32 + i], x2 = KR[r * 32 + 16 + i];
    const float o = (c < 16) ? (x1 * cs.x - x2 * cs.y) : (x2 * cs.x + x1 * cs.y);
    CQ[(size_t)r * 512 + QL + c] = f2bf(o);
}
__global__ void __launch_bounds__(256) k_rope_q(const float* __restrict__ Qraw, const float2* __restrict__ tab, bf16_t* __restrict__ Q) {
    const size_t idx = (size_t)blockIdx.x * 256 + threadIdx.x; if (idx >= (size_t)M * 768) return;
    const int r = (int)(idx / 768), c = (int)(idx % 768), d = c % QHD;
    float o;
    if (d < NOPE) o = Qraw[idx];
    else { const int j = d - NOPE, i = j & 15; const float2 cs = tab[r * 16 + i];
        const size_t b0 = idx - j; const float x1 = Qraw[b0 + i], x2 = Qraw[b0 + 16 + i];
        o = (j < 16) ? (x1 * cs.x - x2 * cs.y) : (x2 * cs.x + x1 * cs.y); }
    Q[idx] = f2bf(o * QSCALE);
}

template <class Epi>
__global__ void __launch_bounds__(256) ref_gemm(const bf16_t* __restrict__ A, int lda, const float* __restrict__ W, int ldw, const float* __restrict__ wscale, int N, int K, Epi epi) {
    __shared__ float As[16][68];
    __shared__ float Ws[16][68];
    const int tid = threadIdx.x, tx = tid & 15, ty = tid >> 4;
    const int m0 = blockIdx.y * 64, n0 = blockIdx.x * 64;
    float acc[4][4];
#pragma unroll
    for (int i = 0; i < 4; ++i)
#pragma unroll
        for (int j = 0; j < 4; ++j) acc[i][j] = 0.f;
    for (int k0 = 0; k0 < K; k0 += 16) {
        { const int r = tid >> 2, kk = (tid & 3) * 4; const uint2 v = *(const uint2*)(A + (size_t)(m0 + r) * lda + k0 + kk);
          As[kk + 0][r] = bf2f(v.x & 0xffffu); As[kk + 1][r] = bf2f(v.x >> 16); As[kk + 2][r] = bf2f(v.y & 0xffffu); As[kk + 3][r] = bf2f(v.y >> 16); }
        { const int kk = tid >> 4, nn = (tid & 15) * 4; const float sc = wscale ? wscale[k0 + kk] : 1.f;
#pragma unroll
          for (int j = 0; j < 4; ++j) { const int n = n0 + nn + j; const float w = (n < N) ? W[(size_t)(k0 + kk) * ldw + n] * sc : 0.f; Ws[kk][nn + j] = bf2f((unsigned)f2bf(w)); } }
        __syncthreads();
#pragma unroll
        for (int kk = 0; kk < 16; ++kk) {
            const float4 a = *(const float4*)&As[kk][ty * 4]; const float4 b = *(const float4*)&Ws[kk][tx * 4];
            acc[0][0] += a.x * b.x; acc[0][1] += a.x * b.y; acc[0][2] += a.x * b.z; acc[0][3] += a.x * b.w;
            acc[1][0] += a.y * b.x; acc[1][1] += a.y * b.y; acc[1][2] += a.y * b.z; acc[1][3] += a.y * b.w;
            acc[2][0] += a.z * b.x; acc[2][1] += a.z * b.y; acc[2][2] += a.z * b.z; acc[2][3] += a.z * b.w;
            acc[3][0] += a.w * b.x; acc[3][1] += a.w * b.y; acc[3][2] += a.w * b.z; acc[3][3] += a.w * b.w;
        }
        __syncthreads();
    }
#pragma unroll
    for (int i = 0; i < 4; ++i)
#pragma unroll
        for (int j = 0; j < 4; ++j) { const int row = m0 + ty * 4 + i, col = n0 + tx * 4 + j; if (col < N) epi(row, col, acc[i][j]); }
}
struct EpiCq { bf16_t* CQ; __device__ void operator()(int r, int c, float v) const { CQ[(size_t)r * 512 + c] = f2bf(v); } };
struct EpiCkv { bf16_t* CKV; __device__ void operator()(int r, int c, float v) const { CKV[(size_t)r * 256 + c] = f2bf(v); } };
struct EpiKr { float* KR; __device__ void operator()(int r, int c, float v) const { KR[(size_t)r * 32 + c] = v; } };
struct EpiU { bf16_t* U2; __device__ void operator()(int r, int c, float v) const { const int b = r / SEQ, t = r % SEQ, g = c >> 4, n = c & 15; U2[(((size_t)b * NG + g) * SEQ + t) * 16 + n] = f2bf(v); } };
struct EpiGate { bf16_t* G; const float* bias; __device__ void operator()(int r, int c, float v) const { G[(size_t)r * DM + c] = f2bf(sigmoidf_(v + bias[c])); } };
struct EpiQraw { float* Qraw; const float* RS; __device__ void operator()(int r, int c, float v) const { Qraw[(size_t)r * 768 + c] = v * RS[2 * r]; } };
struct EpiKv { bf16_t* KN; bf16_t* V; const float* RS; __device__ void operator()(int r, int c, float v) const { v *= RS[2 * r + 1]; const int h = c >> 7, d = c & 127;
    if (d < 64) KN[(size_t)r * 512 + 64 * h + d] = f2bf(v); else V[(size_t)r * 512 + 64 * h + d - 64] = f2bf(v); } };
struct EpiGlu { const bf16_t* YG; bf16_t* AY; const float* b; __device__ void operator()(int r, int c, float v) const { const float y = bf2f(YG[(size_t)r * 512 + c]); AY[(size_t)r * DM + 512 + c] = f2bf(y * sigmoidf_(v + b[c])); } };
struct EpiPP { bf16_t* PP; __device__ void operator()(int r, int c, float v) const { PP[(size_t)r * DM + c] = f2bf(v); } };
struct EpiBrA { const bf16_t* GA; float* T1; __device__ void operator()(int r, int c, float v) const { T1[(size_t)r * DM + c] = bf2f(GA[(size_t)r * DM + c]) * v; } };
struct EpiBrB { const bf16_t* GB; const float* T1; bf16_t* MG; __device__ void operator()(int r, int c, float v) const { MG[(size_t)r * DM + c] = f2bf(T1[(size_t)r * DM + c] + bf2f(GB[(size_t)r * DM + c]) * v); } };
struct EpiWo { const float* x; const float* ST0; const float* g; const float* b; float* out;
    __device__ void operator()(int r, int c, float v) const { const float h0 = (x[(size_t)r * DM + c] - ST0[2 * r]) * ST0[2 * r + 1] * g[c] + b[c]; out[(size_t)r * DM + c] = ALPHA * h0 + v; } };
struct EpiUp { bf16_t* FF; __device__ void operator()(int r, int c, float v) const { const float t = fmaxf(v, 0.f); FF[(size_t)r * DFF + c] = f2bf(t * t); } };
struct EpiDown { float* out; __device__ void operator()(int r, int c, float v) const { out[(size_t)r * DM + c] = ALPHA * out[(size_t)r * DM + c] + v; } };
struct EpiPle { float* out; const bf16_t* PP; const float* b; __device__ void operator()(int r, int c, float v) const { out[(size_t)r * DM + c] = ALPHA * out[(size_t)r * DM + c] + sigmoidf_(v + b[c]) * bf2f(PP[(size_t)r * DM + c]); } };

__global__ void __launch_bounds__(64) ref_attn(const bf16_t* __restrict__ Q, const bf16_t* __restrict__ KN, const bf16_t* __restrict__ CQ, const bf16_t* __restrict__ V, bf16_t* __restrict__ AY) {
    __shared__ float Ks[64][97];
    __shared__ float Vs[64][65];
    const int qt = blockIdx.x, h = blockIdx.y, b = blockIdx.z, tid = threadIdx.x;
    const size_t qrow = (size_t)b * SEQ + qt * 64 + tid;
    float q[QHD], o[VD];
#pragma unroll
    for (int d = 0; d < QHD; ++d) q[d] = bf2f(Q[qrow * 768 + h * QHD + d]);
#pragma unroll
    for (int d = 0; d < VD; ++d) o[d] = 0.f;
    float m = -1e30f, l = 0.f;
    for (int kt = 0; kt <= qt; ++kt) {
        __syncthreads();
        { const size_t krow = (size_t)b * SEQ + kt * 64 + tid;
          for (int d = 0; d < NOPE; ++d) Ks[tid][d] = bf2f(KN[krow * 512 + h * 64 + d]);
          for (int d = 0; d < ROPE; ++d) Ks[tid][NOPE + d] = bf2f(CQ[krow * 512 + QL + d]);
          for (int d = 0; d < VD; ++d) Vs[tid][d] = bf2f(V[krow * 512 + h * 64 + d]); }
        __syncthreads();
        for (int j = 0; j < 64; ++j) {
            if (kt < qt || j <= tid) {
                float s = 0.f;
#pragma unroll
                for (int d = 0; d < QHD; ++d) s += q[d] * Ks[j][d];
                if (s > m) { const float sc = exp2f(m - s); l *= sc;
#pragma unroll
                    for (int d = 0; d < VD; ++d) o[d] *= sc;
                    m = s; }
                const float p = exp2f(s - m); l += p;
#pragma unroll
                for (int d = 0; d < VD; ++d) o[d] += p * Vs[j][d];
            }
        }
    }
    const float rl = 1.0f / l;
#pragma unroll
    for (int d = 0; d < VD; ++d) AY[qrow * DM + h * VD + d] = f2bf(o[d] * rl);
}

__global__ void __launch_bounds__(64) ref_s5(const bf16_t* __restrict__ U2, const float* __restrict__ a_re, const float* __restrict__ a_im, const float* __restrict__ log_dt,
                                             const float* __restrict__ b_re, const float* __restrict__ b_im, const float* __restrict__ c_re, const float* __restrict__ c_im,
                                             const float* __restrict__ d_skip, bf16_t* __restrict__ YG) {
    __shared__ float us[64][17];
    __shared__ float xs[64][129];
    __shared__ float Cm[128][16];
    const int g = blockIdx.x, b = blockIdx.y, p = threadIdx.x;
    float ar, ai, bbr[16], bbi[16];
    {
        const double dt = (double)__expf(log_dt[g]);
        const double lr = (double)fminf(a_re[g * SP + p], -1e-4f), li = (double)a_im[g * SP + p];
        const double mag = exp_small_d(lr * dt); double sn, cs; sincos_d(li * dt, sn, cs);
        const double abr = mag * cs, abi = mag * sn;
        const double den = lr * lr + li * li, nr = abr - 1.0, ni = abi;
        const double fr = (nr * lr + ni * li) / den, fi = (ni * lr - nr * li) / den;
        ar = (float)abr; ai = (float)abi;
#pragma unroll
        for (int n = 0; n < 16; ++n) { const double br = (double)b_re[((size_t)g * SP + p) * SG + n], bi = (double)b_im[((size_t)g * SP + p) * SG + n];
            bbr[n] = (float)(fr * br - fi * bi); bbi[n] = (float)(fr * bi + fi * br); }
        for (int n = 0; n < 16; ++n) { Cm[p][n] = c_re[((size_t)g * SG + n) * SP + p]; Cm[64 + p][n] = -c_im[((size_t)g * SG + n) * SP + p]; }
    }
    float dsk[16];
#pragma unroll
    for (int n = 0; n < 16; ++n) dsk[n] = d_skip[g * SG + n];
    float xr = 0.f, xi = 0.f;
    const bf16_t* ub = U2 + ((size_t)b * NG + g) * SEQ * 16;
    for (int t0 = 0; t0 < SEQ; t0 += 64) {
        __syncthreads();
        for (int n = 0; n < 16; ++n) us[p][n] = bf2f(ub[(size_t)(t0 + p) * 16 + n]);
        __syncthreads();
        for (int tt = 0; tt < 64; ++tt) {
            float br = 0.f, bi = 0.f;
#pragma unroll
            for (int n = 0; n < 16; ++n) { const float uv = us[tt][n]; br += bbr[n] * uv; bi += bbi[n] * uv; }
            const float nr = ar * xr - ai * xi + br, ni = ar * xi + ai * xr + bi; xr = nr; xi = ni;
            xs[tt][p] = xr; xs[tt][64 + p] = xi;
        }
        __syncthreads();
        float y[16];
#pragma unroll
        for (int n = 0; n < 16; ++n) y[n] = dsk[n] * us[p][n];
        for (int k = 0; k < 128; ++k) { const float xv = xs[p][k];
#pragma unroll
            for (int n = 0; n < 16; ++n) y[n] += xv * Cm[k][n]; }
        bf16_t* yo = YG + ((size_t)b * SEQ + t0 + p) * SW + g * SG;
#pragma unroll
        for (int n = 0; n < 16; ++n) yo[n] = f2bf(gelu_tanh(y[n]));
    }
}

constexpr size_t WS_WIN = 2 * MiB;
constexpr int NIN_PAD = 3328;
constexpr size_t WS_WUQ = WS_WIN + (size_t)NIN_PAD * DM * 2;
constexpr size_t WS_WUKV = WS_WUQ + (size_t)768 * QL * 2;
constexpr size_t WS_WGLU = WS_WUKV + (size_t)1024 * KVL * 2;
constexpr size_t WS_WPLE = WS_WGLU + (size_t)SW * SW * 2;
constexpr size_t WS_WBR = WS_WPLE + (size_t)DM * PLE * 2;
constexpr size_t WS_WO = WS_WBR + (size_t)DM * DM * 2;
constexpr size_t WS_WUP = WS_WO + (size_t)DM * DM * 2;
constexpr size_t WS_WDOWN = WS_WUP + (size_t)DFF * DM * 2;
constexpr size_t WS_WPG = WS_WDOWN + (size_t)DM * DFF * 2;
constexpr size_t WS_WEND = WS_WPG + (size_t)DM * DM * 2;
static_assert(WS_WEND <= WS_ST0, "weights fit below ST0");
constexpr size_t WS_SSQ = 35 * MiB;
static_assert(WS_SSQ + (size_t)M * 16 * 4 <= WS_ROPE, "ssq region");
constexpr size_t CTL_ZERO_BYTES = 1 * MiB;

namespace pg8 {
#define PG8_LAS __attribute__((address_space(3)))
typedef short bf16x8 __attribute__((ext_vector_type(8)));
typedef float f32x4 __attribute__((ext_vector_type(4)));
typedef float f32x2 __attribute__((ext_vector_type(2)));
typedef unsigned u32x4 __attribute__((ext_vector_type(4)));
typedef unsigned u32x2 __attribute__((ext_vector_type(2)));
constexpr int BM = 256, BK = 64, HALF = 128, HTB = HALF * BK * 2, STAGE_BYTES = 8 * HTB, NXCD = 8, WGM = 8;

__host__ __device__ __forceinline__ int lds_byte(int r, int c) { const int st = (r >> 4) * 2 + (c >> 5), rr = r & 15, cc = c & 31, ob = rr * 64 + cc * 2; return st * 1024 + (ob ^ (((ob >> 9) & 1) << 5)); }
__host__ __device__ __forceinline__ void stage_rc(int b, int& R, int& C) { const int st = b / 1024, sb = b % 1024, swz = sb ^ (((sb >> 9) & 1) << 5); R = (st >> 1) * 16 + swz / 64; C = (st & 1) * 32 + (swz % 64) / 2; }

struct Unit { int pm, pn; };
struct Gemm { const bf16_t* A; const bf16_t* Bt; int lda; int N, K; int tmid; };

struct StaticOrder {
    int nM, nN, nwg, G, c, i0, i1;
    __host__ __device__ void init(int Mrows, int N, int G_, int c_, int i0_ = 0, int i1_ = 1 << 20) { nM = Mrows / BM; nN = N / BM; nwg = nM * nN; G = G_; c = c_; i0 = i0_; i1 = i1_; }
    __host__ __device__ bool next(int i, Unit& u) const {
        i += i0; if (i >= i1) return false;
        const long L = (long)i * G + c; if (L >= nwg) return false;
        int wgid = (int)L; { const int q = nwg / NXCD, r = nwg % NXCD, xcd = wgid % NXCD, off = wgid / NXCD; wgid = (xcd < r ? xcd * (q + 1) : r * (q + 1) + (xcd - r) * q) + off; }
        const int nig = WGM * nN, gid = wgid / nig, fm = gid * WGM, gsz = (nM - fm) < WGM ? (nM - fm) : WGM;
        u.pm = fm + ((wgid % nig) % gsz); u.pn = (wgid % nig) / gsz; return true;
    }
};

__device__ __forceinline__ unsigned cvt_pk_bf16(float lo, float hi) { unsigned r; asm volatile("v_cvt_pk_bf16_f32 %0, %1, %2" : "=v"(r) : "v"(lo), "v"(hi)); return r; }
__device__ __forceinline__ u32x4 pack8(const f32x4 a, const f32x4 b) { u32x4 w; w.x = cvt_pk_bf16(a[0], a[1]); w.y = cvt_pk_bf16(a[2], a[3]); w.z = cvt_pk_bf16(b[0], b[1]); w.w = cvt_pk_bf16(b[2], b[3]); return w; }
__device__ __forceinline__ u32x2 pack4(const f32x4 a) { u32x2 w; w.x = cvt_pk_bf16(a[0], a[1]); w.y = cvt_pk_bf16(a[2], a[3]); return w; }
__device__ __forceinline__ float fsig(float v) { return __builtin_amdgcn_rcpf(1.0f + __builtin_amdgcn_exp2f(-1.4426950408889634f * v)); }
__device__ __forceinline__ f32x4 fsig4(f32x4 v) { f32x4 o; o[0] = fsig(v[0]); o[1] = fsig(v[1]); o[2] = fsig(v[2]); o[3] = fsig(v[3]); return o; }
__device__ __forceinline__ f32x4 bf4_to_f32(u32x2 w) { f32x4 o; o[0] = __uint_as_float(w.x << 16); o[1] = __uint_as_float(w.x & 0xffff0000u); o[2] = __uint_as_float(w.y << 16); o[3] = __uint_as_float(w.y & 0xffff0000u); return o; }

typedef f32x4 Acc[2][2][4][2];

struct EpiIn {
    static constexpr bool AFTER_DRAIN = false, HAS_MID = false;
    bf16_t *CQ, *CKV, *U2, *GA, *GB; float* SSQ; const float2* RT; const float* bgate;
    __device__ __forceinline__ void mid(Acc&, const Unit&, int, int, int, int) const {}
    __device__ __forceinline__ void operator()(const Acc& acc, const Unit& u, int wr, int wc, int fr, int fq) const {
        const int pn = u.pn, row0 = u.pm * BM + wr * 64 + fr;
        if (pn <= 2) {
#pragma unroll
            for (int ai = 0; ai < 2; ++ai)
#pragma unroll
                for (int m = 0; m < 4; ++m) { const int row = row0 + ai * HALF + m * 16; float ss = 0.f;
#pragma unroll
                    for (int bj = 0; bj < 2; ++bj) { const f32x4 v0 = acc[ai][bj][m][0], v1 = acc[ai][bj][m][1];
                        if (pn == 1 && bj == 1) {
                            if (wc == 0) {
                                const f32x4 t0 = *(const f32x4*)((const float*)RT + ((size_t)row * 16 + 4 * fq) * 2), t1 = *(const f32x4*)((const float*)RT + ((size_t)row * 16 + 4 * fq) * 2 + 4);
                                const f32x4 cs = {t0[0], t0[2], t1[0], t1[2]}, sn = {t0[1], t0[3], t1[1], t1[3]};
                                const f32x4 o1 = v0 * cs - v1 * sn, o2 = v1 * cs + v0 * sn;
                                *(u32x2*)(CQ + (size_t)row * 512 + QL + 4 * fq) = pack4(o1); *(u32x2*)(CQ + (size_t)row * 512 + QL + 16 + 4 * fq) = pack4(o2);
                            }
                        } else {
                            ss += (v0[0] * v0[0] + v0[1] * v0[1]) + (v0[2] * v0[2] + v0[3] * v0[3]) + (v1[0] * v1[0] + v1[1] * v1[1]) + (v1[2] * v1[2] + v1[3] * v1[3]);
                            bf16_t* dst = (pn < 2) ? CQ + (size_t)row * 512 + 256 * pn + 128 * bj + 32 * wc + 8 * fq : CKV + (size_t)row * 256 + 128 * bj + 32 * wc + 8 * fq;
                            *(u32x4*)dst = pack8(v0, v1);
                        } }
                    ss += __shfl_xor(ss, 16); ss += __shfl_xor(ss, 32);
                    if (fq == 0) SSQ[(size_t)row * 16 + 4 * pn + wc] = ss; asm volatile("" ::: "memory"); }
        } else if (pn <= 4) {
#pragma unroll
            for (int ai = 0; ai < 2; ++ai)
#pragma unroll
                for (int m = 0; m < 4; ++m) { const int row = row0 + ai * HALF + m * 16, b = row / SEQ, t = row % SEQ;
#pragma unroll
                    for (int bj = 0; bj < 2; ++bj) { const int c = 256 * (pn - 3) + 128 * bj + 32 * wc + 8 * fq, g = c >> 4, n0 = c & 15;
                        *(u32x4*)(U2 + (((size_t)b * NG + g) * SEQ + t) * 16 + n0) = pack8(acc[ai][bj][m][0], acc[ai][bj][m][1]); } }
        } else {
            const int gi = pn - 5; bf16_t* G = (gi < 4) ? GA : GB; const float* bia = bgate + ((gi < 4) ? 0 : DM);
#pragma unroll
            for (int bj = 0; bj < 2; ++bj) { const int c = 256 * (gi & 3) + 128 * bj + 32 * wc + 8 * fq; const f32x4 b0 = *(const f32x4*)(bia + c), b1 = *(const f32x4*)(bia + c + 4);
#pragma unroll
                for (int ai = 0; ai < 2; ++ai)
#pragma unroll
                    for (int m = 0; m < 4; ++m) { const int row = row0 + ai * HALF + m * 16;
                        *(u32x4*)(G + (size_t)row * DM + c) = pack8(fsig4(acc[ai][bj][m][0] + b0), fsig4(acc[ai][bj][m][1] + b1)); } }
        }
    }
};
struct EpiQ {
    static constexpr bool AFTER_DRAIN = false, HAS_MID = false;
    bf16_t* Q; const float* SSQ; const float2* RT;
    __device__ __forceinline__ void mid(Acc&, const Unit&, int, int, int, int) const {}
    __device__ __forceinline__ void operator()(const Acc& acc, const Unit& u, int wr, int wc, int fr, int fq) const {
        const int row0 = u.pm * BM + wr * 64 + fr;
        float rs[2][4];
#pragma unroll
        for (int ai = 0; ai < 2; ++ai)
#pragma unroll
            for (int m = 0; m < 4; ++m) { const float* sp = SSQ + (size_t)(row0 + ai * HALF + m * 16) * 16; const f32x4 s0 = *(const f32x4*)sp, s1 = *(const f32x4*)(sp + 4);
                rs[ai][m] = QSCALE * __builtin_amdgcn_rsqf(((s0[0] + s0[1]) + (s0[2] + s0[3]) + (s1[0] + s1[1]) + (s1[2] + s1[3])) * (1.0f / QL) + RMS_EPS); }
        asm volatile("" ::: "memory");
#pragma unroll
        for (int bj = 0; bj < 2; ++bj) { const int grp = 8 * u.pn + 4 * bj + wc;
            if (grp % 3 == 2) {
#pragma unroll
                for (int ai = 0; ai < 2; ++ai)
#pragma unroll
                    for (int m = 0; m < 4; ++m) { const int row = row0 + ai * HALF + m * 16; const float* tp = (const float*)RT + ((size_t)row * 16 + 4 * fq) * 2;
                        const f32x4 t0 = *(const f32x4*)tp, t1 = *(const f32x4*)(tp + 4);
                        const f32x4 cs = {t0[0], t0[2], t1[0], t1[2]}, sn = {t0[1], t0[3], t1[1], t1[3]};
                        const f32x4 v0 = acc[ai][bj][m][0] * rs[ai][m], v1 = acc[ai][bj][m][1] * rs[ai][m];
                        const f32x4 o1 = v0 * cs - v1 * sn, o2 = v1 * cs + v0 * sn; bf16_t* qp = Q + (size_t)row * 768 + 32 * grp + 4 * fq;
                        *(u32x2*)qp = pack4(o1); *(u32x2*)(qp + 16) = pack4(o2); asm volatile("" ::: "memory"); }
            } else {
#pragma unroll
                for (int ai = 0; ai < 2; ++ai)
#pragma unroll
                    for (int m = 0; m < 4; ++m) { const int row = row0 + ai * HALF + m * 16;
                        *(u32x4*)(Q + (size_t)row * 768 + 32 * grp + 8 * fq) = pack8(acc[ai][bj][m][0] * rs[ai][m], acc[ai][bj][m][1] * rs[ai][m]); }
            } }
    }
};
struct EpiKV {
    static constexpr bool AFTER_DRAIN = false, HAS_MID = false;
    bf16_t *KN, *V; const float* SSQ;
    __device__ __forceinline__ void mid(Acc&, const Unit&, int, int, int, int) const {}
    __device__ __forceinline__ void operator()(const Acc& acc, const Unit& u, int wr, int wc, int fr, int fq) const {
        const int row0 = u.pm * BM + wr * 64 + fr; bf16_t* base = (u.pn < 2) ? KN : V; const int c0 = 256 * (u.pn & 1) + 32 * wc + 8 * fq;
#pragma unroll
        for (int ai = 0; ai < 2; ++ai)
#pragma unroll
            for (int m = 0; m < 4; ++m) { const int row = row0 + ai * HALF + m * 16;
                const f32x4 s0 = *(const f32x4*)(SSQ + (size_t)row * 16 + 8);
                const float rs = __builtin_amdgcn_rsqf(((s0[0] + s0[1]) + (s0[2] + s0[3])) * (1.0f / KVL) + RMS_EPS);
#pragma unroll
                for (int bj = 0; bj < 2; ++bj) *(u32x4*)(base + (size_t)row * 512 + c0 + 128 * bj) = pack8(acc[ai][bj][m][0] * rs, acc[ai][bj][m][1] * rs);
                asm volatile("" ::: "memory"); }
    }
};
struct EpiGluF {
    static constexpr bool AFTER_DRAIN = false, HAS_MID = false;
    const bf16_t* YG; bf16_t* AY; const float* bias;
    __device__ __forceinline__ void mid(Acc&, const Unit&, int, int, int, int) const {}
    __device__ __forceinline__ void operator()(const Acc& acc, const Unit& u, int wr, int wc, int fr, int fq) const {
        const int row0 = u.pm * BM + wr * 64 + fr;
#pragma unroll
        for (int bj = 0; bj < 2; ++bj) { const int c = 256 * u.pn + 128 * bj + 32 * wc + 8 * fq; const f32x4 b0 = *(const f32x4*)(bias + c), b1 = *(const f32x4*)(bias + c + 4);
#pragma unroll
            for (int ai = 0; ai < 2; ++ai)
#pragma unroll
                for (int m = 0; m < 4; ++m) { const int row = row0 + ai * HALF + m * 16; const u32x4 yw = *(const u32x4*)(YG + (size_t)row * SW + c);
                    const f32x4 y0 = bf4_to_f32((u32x2){yw.x, yw.y}), y1 = bf4_to_f32((u32x2){yw.z, yw.w});
                    *(u32x4*)(AY + (size_t)row * DM + 512 + c) = pack8(y0 * fsig4(acc[ai][bj][m][0] + b0), y1 * fsig4(acc[ai][bj][m][1] + b1)); } }
    }
};
template <int ACT> struct EpiStore {
    static constexpr bool AFTER_DRAIN = false, HAS_MID = false;
    bf16_t* O; int ldc;
    __device__ __forceinline__ void mid(Acc&, const Unit&, int, int, int, int) const {}
    __device__ __forceinline__ void operator()(const Acc& acc, const Unit& u, int wr, int wc, int fr, int fq) const {
        const int row0 = u.pm * BM + wr * 64 + fr, c0 = 256 * u.pn + 32 * wc + 8 * fq;
#pragma unroll
        for (int ai = 0; ai < 2; ++ai)
#pragma unroll
            for (int m = 0; m < 4; ++m) { bf16_t* rowp = O + (size_t)(row0 + ai * HALF + m * 16) * ldc + c0;
#pragma unroll
                for (int bj = 0; bj < 2; ++bj) { f32x4 v0 = acc[ai][bj][m][0], v1 = acc[ai][bj][m][1];
                    if (ACT == 1) { const f32x4 z = {0.f, 0.f, 0.f, 0.f}; v0 = __builtin_elementwise_max(v0, z); v1 = __builtin_elementwise_max(v1, z); v0 = v0 * v0; v1 = v1 * v1; }
                    *(u32x4*)(rowp + bj * HALF) = pack8(v0, v1); } }
    }
};
struct EpiMerge {
    static constexpr bool AFTER_DRAIN = false, HAS_MID = true;
    const bf16_t *GA, *GB; bf16_t* MG;
    __device__ __forceinline__ void mid(Acc& acc, const Unit& u, int wr, int wc, int fr, int fq) const {
        const int row0 = u.pm * BM + wr * 64 + fr, c0 = 256 * u.pn + 32 * wc + 8 * fq;
#pragma unroll
        for (int ai = 0; ai < 2; ++ai)
#pragma unroll
            for (int m = 0; m < 4; ++m) { const size_t off = (size_t)(row0 + ai * HALF + m * 16) * DM + c0;
#pragma unroll
                for (int bj = 0; bj < 2; ++bj) { const u32x4 a = *(const u32x4*)(GA + off + bj * HALF), b = *(const u32x4*)(GB + off + bj * HALF);
                    const f32x4 a0 = bf4_to_f32((u32x2){a.x, a.y}), a1 = bf4_to_f32((u32x2){a.z, a.w}), b0 = bf4_to_f32((u32x2){b.x, b.y}), b1 = bf4_to_f32((u32x2){b.z, b.w});
                    f32x4 r0, r1;
#pragma unroll
                    for (int j = 0; j < 4; ++j) { r0[j] = a0[j] * __builtin_amdgcn_rcpf(b0[j]); r1[j] = a1[j] * __builtin_amdgcn_rcpf(b1[j]); }
                    acc[ai][bj][m][0] *= r0; acc[ai][bj][m][1] *= r1; } }
    }
    __device__ __forceinline__ void operator()(const Acc& acc, const Unit& u, int wr, int wc, int fr, int fq) const {
        const int row0 = u.pm * BM + wr * 64 + fr, c0 = 256 * u.pn + 32 * wc + 8 * fq;
#pragma unroll
        for (int ai = 0; ai < 2; ++ai)
#pragma unroll
            for (int m = 0; m < 4; ++m) { const size_t off = (size_t)(row0 + ai * HALF + m * 16) * DM + c0;
#pragma unroll
                for (int bj = 0; bj < 2; ++bj) { const u32x4 b = *(const u32x4*)(GB + off + bj * HALF);
                    const f32x4 b0 = bf4_to_f32((u32x2){b.x, b.y}), b1 = bf4_to_f32((u32x2){b.z, b.w});
                    *(u32x4*)(MG + off + bj * HALF) = pack8(acc[ai][bj][m][0] * b0, acc[ai][bj][m][1] * b1); } }
    }
};
template <int MODE> struct EpiPre {
    static constexpr bool AFTER_DRAIN = false, HAS_MID = false;
    float* out; const float* x; const float* ST0; const float* g; const float* b; const bf16_t* PP; const float* bias;
    __device__ __forceinline__ void mid(Acc&, const Unit&, int, int, int, int) const {}
    __device__ __forceinline__ void operator()(const Acc& acc, const Unit& u, int wr, int wc, int fr, int fq) const {
        const int row0 = u.pm * BM + wr * 64 + fr, c0 = 256 * u.pn + 32 * wc + 4 * fq;
#pragma unroll
        for (int ai = 0; ai < 2; ++ai)
#pragma unroll
            for (int m = 0; m < 4; ++m) { const int row = row0 + ai * HALF + m * 16; const size_t off = (size_t)row * DM + c0;
                f32x2 st = {0.f, 0.f}; if (MODE == 0) st = *(const f32x2*)(ST0 + 2 * (size_t)row);
#pragma unroll
                for (int bj = 0; bj < 2; ++bj)
#pragma unroll
                    for (int n = 0; n < 2; ++n) { const int cc = bj * HALF + n * 16; f32x4 r;
                        if (MODE == 0) { const f32x4 xv = *(const f32x4*)(x + off + cc), gg = *(const f32x4*)(g + c0 + cc), bb = *(const f32x4*)(b + c0 + cc); r = ALPHA * ((xv - st.x) * st.y * gg + bb) + acc[ai][bj][m][n]; }
                        else if (MODE == 1) r = ALPHA * *(const f32x4*)(out + off + cc) + acc[ai][bj][m][n];
                        else { const f32x4 pp = bf4_to_f32(*(const u32x2*)(PP + off + cc)), bi = *(const f32x4*)(bias + c0 + cc); r = ALPHA * *(const f32x4*)(out + off + cc) + fsig4(acc[ai][bj][m][n] + bi) * pp; }
                        *(f32x4*)(out + off + cc) = r; }
                asm volatile("" ::: "memory"); }
    }
};

template <class Epi, class Sched, bool ALIGN_EPI>
__device__ __forceinline__ void gemm_phase(PG8_LAS unsigned char* lds, const Gemm g, const Sched& S, const Epi& E, const int wid) {
    const int lane = (int)__builtin_amdgcn_mbcnt_hi(~0u, __builtin_amdgcn_mbcnt_lo(~0u, 0u)), tid = wid * 64 + lane, wr = wid >> 2, wc = wid & 3, fr = lane & 15, fq = lane >> 4;
    int K = g.K, lda = g.lda; asm volatile("" : "+s"(K), "+s"(lda));
    const int nt = K / BK;
    unsigned voffA[2], voffB[2];
#pragma unroll
    for (int i = 0; i < 2; ++i) { int R, C; stage_rc(tid * 16 + i * 8192, R, C); voffA[i] = (unsigned)(R * lda + C) * 2u; voffB[i] = (unsigned)(R * K + C) * 2u; }
    const size_t kstep = (size_t)(BK * 2);
    const size_t hstepA = (size_t)HALF * lda * 2, hstepB = (size_t)HALF * K * 2;
    const size_t tstepA = 2 * hstepA, tstepB = 2 * hstepB;
    const unsigned ldsw = (unsigned)wid * 1024u;
    const int aoff = lds_byte(wr * 64 + fr, fq * 8), boff = lds_byte(wc * 32 + fr, fq * 8);
#define PG8_SA(b, h) (((b) * 2 + (h)) * HTB)
#define PG8_SB(b, h) ((4 + (b) * 2 + (h)) * HTB)
#define PG8_STAGE(bufoff, gbase, voff) do { _Pragma("unroll") for (int _i = 0; _i < 2; ++_i) \
        __builtin_amdgcn_global_load_lds((const unsigned*)((const char*)(gbase) + (voff)[_i]), (PG8_LAS unsigned*)(lds + (bufoff) + ldsw + _i * 8192), 16, 0, 0); } while (0)
#define PG8_LDA(dst, b, h) do { _Pragma("unroll") for (int m = 0; m < 4; ++m) _Pragma("unroll") for (int k = 0; k < 2; ++k) dst[m][k] = *(const PG8_LAS bf16x8*)(lds + PG8_SA(b, h) + aoff + m * 2048 + k * 1024); } while (0)
#define PG8_LDB(dst, b, h) do { _Pragma("unroll") for (int n = 0; n < 2; ++n) _Pragma("unroll") for (int k = 0; k < 2; ++k) dst[n][k] = *(const PG8_LAS bf16x8*)(lds + PG8_SB(b, h) + boff + n * 2048 + k * 1024); } while (0)
#define PG8_MMA(ai, bj, At, Bt) do { __builtin_amdgcn_s_setprio(1); _Pragma("unroll") for (int m = 0; m < 4; ++m) _Pragma("unroll") for (int n = 0; n < 2; ++n) _Pragma("unroll") for (int k = 0; k < 2; ++k) \
        acc[ai][bj][m][n] = __builtin_amdgcn_mfma_f32_16x16x32_bf16(Bt[n][k], At[m][k], acc[ai][bj][m][n], 0, 0, 0); __builtin_amdgcn_s_setprio(0); } while (0)
#define PG8_WAIT_V(n) asm volatile("s_waitcnt vmcnt(" #n ")" ::: "memory")
#define PG8_WAIT_L(n) asm volatile("s_waitcnt lgkmcnt(" #n ")" ::: "memory")
#define PG8_BAR __builtin_amdgcn_s_barrier()
#define PG8_SCHED __builtin_amdgcn_sched_barrier(0)
    Unit cur, nxt; int ui = 0;
    if (!S.next(0, cur)) return;
    Acc acc;
#pragma unroll
    for (int a = 0; a < 2; ++a)
#pragma unroll
        for (int b = 0; b < 2; ++b)
#pragma unroll
            for (int m = 0; m < 4; ++m)
#pragma unroll
                for (int n = 0; n < 2; ++n) acc[a][b][m][n] = (f32x4){0.f, 0.f, 0.f, 0.f};
    bf16x8 At[4][2], B0[2][2], B1[2][2];
    const char* cA = (const char*)g.A + (size_t)cur.pm * tstepA; const char* cB = (const char*)g.Bt + (size_t)cur.pn * tstepB;
    PG8_STAGE(PG8_SB(0, 0), cB, voffB); PG8_STAGE(PG8_SB(0, 1), cB + hstepB, voffB); PG8_STAGE(PG8_SA(0, 0), cA, voffA); PG8_STAGE(PG8_SA(0, 1), cA + hstepA, voffA);
    if (wr == 1) PG8_BAR;
    PG8_WAIT_V(2); PG8_BAR;
    PG8_STAGE(PG8_SB(1, 0), cB + kstep, voffB); PG8_STAGE(PG8_SA(1, 0), cA + kstep, voffA); PG8_STAGE(PG8_SB(1, 1), cB + hstepB + kstep, voffB);
    PG8_WAIT_V(6); PG8_BAR;
    for (;;) {
        const bool has_next = S.next(ui + 1, nxt);
        const char* nA = has_next ? (const char*)g.A + (size_t)nxt.pm * tstepA : cA; const char* nB = has_next ? (const char*)g.Bt + (size_t)nxt.pn * tstepB : cB;
#pragma clang loop unroll(disable)
        for (int t = 0; t < nt; t += 2) {
            const bool last = (t == nt - 2);
            const char* a1 = cA + (size_t)(t + 1) * kstep;
            const char* a2 = last ? nA : cA + (size_t)(t + 2) * kstep; const char* b2 = last ? nB : cB + (size_t)(t + 2) * kstep;
            const char* a3 = a2 + kstep; const char* b3 = b2 + kstep;
            if constexpr (Epi::HAS_MID) { if (t == g.tmid) { int l2 = (int)__builtin_amdgcn_mbcnt_hi(~0u, __builtin_amdgcn_mbcnt_lo(~0u, 0u)); asm volatile("" : "+v"(l2)); E.mid(acc, cur, wr, wc, l2 & 15, l2 >> 4); } }
            PG8_LDB(B0, 0, 0); PG8_LDB(B1, 0, 1); PG8_SCHED; PG8_LDA(At, 0, 0); PG8_STAGE(PG8_SA(1, 1), a1 + hstepA, voffA);
            PG8_WAIT_V(8); PG8_WAIT_L(0); PG8_BAR; PG8_MMA(0, 0, At, B0); PG8_MMA(0, 1, At, B1); PG8_BAR; PG8_SCHED;
            PG8_LDA(At, 0, 1); PG8_STAGE(PG8_SB(0, 0), b2, voffB); PG8_STAGE(PG8_SB(0, 1), b2 + hstepB, voffB); PG8_STAGE(PG8_SA(0, 0), a2, voffA);
            PG8_WAIT_V(8); PG8_WAIT_L(0); PG8_BAR; PG8_MMA(1, 0, At, B0); PG8_MMA(1, 1, At, B1); PG8_BAR; PG8_SCHED;
            PG8_LDB(B0, 1, 0); PG8_LDB(B1, 1, 1); PG8_SCHED; PG8_LDA(At, 1, 0); PG8_STAGE(PG8_SA(0, 1), a2 + hstepA, voffA);
            PG8_WAIT_V(8); PG8_WAIT_L(0); PG8_BAR; PG8_MMA(0, 0, At, B0); PG8_MMA(0, 1, At, B1); PG8_BAR; PG8_SCHED;
            PG8_LDA(At, 1, 1); PG8_STAGE(PG8_SB(1, 0), b3, voffB); PG8_STAGE(PG8_SB(1, 1), b3 + hstepB, voffB); PG8_STAGE(PG8_SA(1, 0), a3, voffA);
            PG8_WAIT_V(8); PG8_WAIT_L(0); PG8_BAR; PG8_MMA(1, 0, At, B0); PG8_MMA(1, 1, At, B1); PG8_BAR; PG8_SCHED;
        }
        if constexpr (ALIGN_EPI) { if (wr == 0) PG8_BAR; }
        if constexpr (!Epi::AFTER_DRAIN) { int l2 = (int)__builtin_amdgcn_mbcnt_hi(~0u, __builtin_amdgcn_mbcnt_lo(~0u, 0u)); asm volatile("" : "+v"(l2));
            E(acc, cur, wr, wc, l2 & 15, l2 >> 4); }
        if (!has_next) break;
#pragma unroll
        for (int a = 0; a < 2; ++a)
#pragma unroll
            for (int b = 0; b < 2; ++b)
#pragma unroll
                for (int m = 0; m < 4; ++m)
#pragma unroll
                    for (int n = 0; n < 2; ++n) acc[a][b][m][n] = (f32x4){0.f, 0.f, 0.f, 0.f};
        cur = nxt; cA = nA; cB = nB; ++ui;
        if constexpr (ALIGN_EPI) { if (wr == 1) PG8_BAR; }
    }
    PG8_WAIT_V(0);
    if constexpr (!ALIGN_EPI) { if (wr == 0) PG8_BAR; }
    PG8_BAR;
    if constexpr (Epi::AFTER_DRAIN) { E.fused(acc, cur, wr, wc, fr, fq, lds, wid, lane); }
#undef PG8_SA
#undef PG8_SB
#undef PG8_STAGE
#undef PG8_LDA
#undef PG8_LDB
#undef PG8_MMA
#undef PG8_WAIT_V
#undef PG8_WAIT_L
#undef PG8_BAR
#undef PG8_SCHED
}
}

constexpr int NWAVES = 8;
constexpr int RING_OFF = 0, RING_BYTES = 131072;
constexpr int LDSCTL_OFF = RING_BYTES, MISC_OFF = LDSCTL_OFF + 320;
constexpr int LDS_BYTES = 147456;
#define GAS __attribute__((address_space(1)))
#define LAS __attribute__((address_space(3)))
typedef unsigned v4u __attribute__((ext_vector_type(4)));
typedef GAS unsigned gu32;
#define RLX_AGENT __ATOMIC_RELAXED, __HIP_MEMORY_SCOPE_AGENT
#define LDS_WAIT() asm volatile("s_waitcnt lgkmcnt(0)" ::: "memory")
#define VM_WAIT() asm volatile("s_waitcnt vmcnt(0)" ::: "memory")
constexpr int CW_TMO = 0, CW_CODE = 1, CW_BAR = 4096;

#define XB_TMO      128
#define XB_XCNT(j)  (256  + 64 * (j))
#define XB_XSUB(j)  (1280 + 64 * (j))
#define XB_XGEN(j)  (2304 + 64 * (j))
#define XB_TOP      3328
#define XB_TOPGEN   3392
#define XCD_BAR_WORDS 3456
#define XB_SPIN_CAP (1u << 18)
__device__ __forceinline__ unsigned xb_ld(unsigned* p)              { return __hip_atomic_load(p, __ATOMIC_RELAXED, __HIP_MEMORY_SCOPE_AGENT); }
__device__ __forceinline__ unsigned xb_add(unsigned* p, unsigned v) { return __hip_atomic_fetch_add(p, v, __ATOMIC_RELAXED, __HIP_MEMORY_SCOPE_AGENT); }
__device__ __forceinline__ unsigned xb_xcc_id() { return (unsigned)__builtin_amdgcn_s_getreg((3 << 11) | 20) & 0xFu; }
#define XB_SPIN(cond, bar) do { unsigned _sp = 0; while (cond) { __builtin_amdgcn_s_sleep(1); \
    if ((++_sp & 255u) == 0u) { if (xb_ld(&(bar)[XB_TMO])) break; if (_sp > XB_SPIN_CAP) { atomicAdd(&(bar)[XB_TMO], 1u); break; } } } } while (0)
struct XcdBarrier { unsigned* bar; unsigned x; volatile LAS unsigned* st; };
__device__ __forceinline__ XcdBarrier xcd_barrier_post(unsigned* bar, volatile LAS unsigned* st) {
    XcdBarrier b; b.bar = bar; b.x = xb_xcc_id(); b.st = st;
    if (threadIdx.x == 0) (void)xb_add(&bar[XB_XCNT(b.x)], 1u);
    return b;
}
__device__ __forceinline__ void xcd_barrier_complete(unsigned* bar, unsigned x, unsigned& nloc, unsigned& nx) {
    const unsigned G = gridDim.x * gridDim.y * gridDim.z;
    unsigned sum, cnt, mine, sp = 0u;
    for (;;) {
        sum = 0u; cnt = 0u; mine = 0u;
#pragma unroll
        for (unsigned j = 0; j < 16; ++j) { const unsigned c = xb_ld(&bar[XB_XCNT(j)]); sum += c; cnt += (c > 0u) ? 1u : 0u; mine = (j == x) ? c : mine; }
        if (sum == G) break;
        __builtin_amdgcn_s_sleep(1);
        if ((++sp & 255u) == 0u) { if (xb_ld(&bar[XB_TMO])) break; if (sp > XB_SPIN_CAP) { atomicAdd(&bar[XB_TMO], 1u); break; } }
    }
    nloc = mine > 0u ? mine : 1u; nx = cnt > 0u ? cnt : 1u;
}
__device__ __forceinline__ void xcd_barrier(const XcdBarrier& b, const int wave) {
    asm volatile("s_waitcnt vmcnt(0)" ::: "memory");
    __syncthreads();
    if (wave == 0 && (int)__builtin_amdgcn_mbcnt_hi(~0u, __builtin_amdgcn_mbcnt_lo(~0u, 0u)) == 0) {
        unsigned* bar = b.bar;
        __builtin_amdgcn_s_waitcnt(0);
        unsigned nloc = b.st[0], nx = b.st[1];
        if (nloc == 0u) { xcd_barrier_complete(bar, b.x, nloc, nx); b.st[0] = nloc; b.st[1] = nx; }
        const unsigned old = xb_add(&bar[XB_XSUB(b.x)], 1u);
        const unsigned gen = old / nloc;
        if (old + 1u == (gen + 1u) * nloc) {
            __builtin_amdgcn_fence(__ATOMIC_RELEASE, "agent");
            asm volatile("s_waitcnt vmcnt(0)" ::: "memory");
            const unsigned og = xb_add(&bar[XB_TOP], 1u);
            const unsigned tg = og / nx;
            if (og + 1u == (tg + 1u) * nx) xb_add(&bar[XB_TOPGEN], 1u);
            else XB_SPIN(xb_ld(&bar[XB_TOPGEN]) == tg, bar);
            __builtin_amdgcn_fence(__ATOMIC_ACQUIRE, "agent");
            xb_add(&bar[XB_XGEN(b.x)], 1u);
            asm volatile("s_waitcnt vmcnt(0)" ::: "memory");
        } else {
            XB_SPIN(xb_ld(&bar[XB_XGEN(b.x)]) == gen, bar);
            __builtin_amdgcn_fence(__ATOMIC_ACQUIRE, "agent");
            asm volatile("s_waitcnt vmcnt(0)" ::: "memory");
        }
    }
    __syncthreads();
}

__device__ __forceinline__ unsigned f2bf_u(float f) { unsigned u = __builtin_bit_cast(unsigned, f); return (u + 0x7fffu + ((u >> 16) & 1u)) >> 16; }
__device__ __forceinline__ unsigned pk2(float lo, float hi) { return f2bf_u(lo) | (f2bf_u(hi) << 16); }
__device__ __forceinline__ int p8(int r) { const int f = r & 31, n = f >> 4, i = f & 15; return (r & ~31) + 8 * (i >> 2) + 4 * n + (i & 3); }
enum { MAP_ID = 0, MAP_P8 = 1, MAP_WIN = 2, MAP_WUQ = 3, MAP_WUKV = 4 };
__device__ __forceinline__ int tr_srccol(int map, int r) {
    switch (map) {
    case MAP_ID: return r;
    case MAP_P8: return p8(r);
    case MAP_WIN:
        if (r < QL) return OFF_CQ + p8(r);
        if (r < QL + ROPE) return OFF_KR + (r - QL);
        if (r < 512) return -1;
        if (r < 768) return OFF_CKV + p8(r - 512);
        if (r < 1280) return OFF_U + p8(r - 768);
        if (r < 2304) return OFF_GA + p8(r - 1280);
        return OFF_GB + p8(r - 2304);
    case MAP_WUQ: return (((r >> 5) % 3) == 2) ? r : p8(r);
    default: { const int c = p8(r), cc = c & 511, h = cc >> 6, d = cc & 63; return 128 * h + d + ((c >= 512) ? 64 : 0); }
    }
}
struct TrDesc { const float* W; int ldw; int Ksrc; bf16_t* WT; int Kdst; int koff; int Ndst; int map; const float* kscale; };
__device__ __forceinline__ void tr_item(const TrDesc& d, LAS float* scr, int item, int lane) {
    const int nblk = d.Ndst / 32, kb = item / nblk, nb = item % nblk, k0 = 64 * kb, n0 = 32 * nb;
    const int sc = tr_srccol(d.map, n0 + (lane & 31));
#pragma unroll 8
    for (int i = 0; i < 32; ++i) { const int kk = 2 * i + (lane >> 5); float v = (sc >= 0) ? d.W[(size_t)(k0 + kk) * d.ldw + sc] : 0.f; if (d.kscale) v *= d.kscale[k0 + kk]; scr[kk * 33 + (lane & 31)] = v; }
    LDS_WAIT(); asm volatile("" ::: "memory");
    const int c = lane & 7;
#pragma unroll
    for (int j = 0; j < 4; ++j) { const int n = (lane >> 3) + 8 * j; const LAS float* s = scr + (8 * c) * 33 + n;
        v4u o; o.x = pk2(s[0 * 33], s[1 * 33]); o.y = pk2(s[2 * 33], s[3 * 33]); o.z = pk2(s[4 * 33], s[5 * 33]); o.w = pk2(s[6 * 33], s[7 * 33]);
        *(GAS v4u*)(d.WT + (size_t)(n0 + n) * d.Kdst + d.koff + k0 + 8 * c) = o; }
    LDS_WAIT(); asm volatile("" ::: "memory");
}

struct Args { const void* in[35]; float* out; unsigned char* ws; int ph_lo, ph_hi, li, pad; };
enum { PH_PRO = 0, PH_IN = 1, PH_QKV = 2, PH_MIX = 3, PH_GLU = 4, PH_MERGE = 5, PH_WO = 6, PH_LN1 = 7, PH_UP = 8, PH_DOWN = 9, PH_LN2 = 10, PH_PLE = 11, PH_LN3 = 12, PH_END = 13 };

__device__ __forceinline__ void ln_rows(int gw, int NGW, int lane, float* io, bf16_t* xn, const float* __restrict__ g, const float* __restrict__ b) {
    typedef float f4 __attribute__((ext_vector_type(4)));
    const f4 g0 = ((const f4*)g)[lane], g1 = ((const f4*)g)[lane + 64], g2 = ((const f4*)g)[lane + 128], g3 = ((const f4*)g)[lane + 192];
    const f4 b0 = ((const f4*)b)[lane], b1 = ((const f4*)b)[lane + 64], b2 = ((const f4*)b)[lane + 128], b3 = ((const f4*)b)[lane + 192];
    for (int m = gw; m < M; m += NGW) {
        GAS f4* xr = (GAS f4*)(io + (size_t)m * DM) + lane;
        f4 v[4]; float s = 0.f;
#pragma unroll
        for (int j = 0; j < 4; ++j) { v[j] = xr[64 * j]; s += (v[j].x + v[j].y) + (v[j].z + v[j].w); }
#pragma unroll
        for (int o = 1; o < 64; o <<= 1) s += __shfl_xor(s, o);
        const float mean = s * (1.f / DM); float s2 = 0.f;
#pragma unroll
        for (int j = 0; j < 4; ++j) { v[j] = v[j] - mean; s2 += (v[j].x * v[j].x + v[j].y * v[j].y) + (v[j].z * v[j].z + v[j].w * v[j].w); }
#pragma unroll
        for (int o = 1; o < 64; o <<= 1) s2 += __shfl_xor(s2, o);
        const float rstd = 1.0f / sqrtf(s2 * (1.f / DM) + LN_EPS);
        v[0] = v[0] * rstd * g0 + b0; v[1] = v[1] * rstd * g1 + b1; v[2] = v[2] * rstd * g2 + b2; v[3] = v[3] * rstd * g3 + b3;
#pragma unroll
        for (int j = 0; j < 4; ++j) xr[64 * j] = v[j];
        if (xn) { GAS unsigned long long* o8 = (GAS unsigned long long*)(xn + (size_t)m * DM) + lane;
#pragma unroll
            for (int j = 0; j < 4; ++j) o8[64 * j] = (unsigned long long)pk2(v[j].x, v[j].y) | ((unsigned long long)pk2(v[j].z, v[j].w) << 32); }
    }
}

__global__ void __launch_bounds__(NWAVES * 64, 2) mk_fwd(Args args) {
    extern __shared__ __attribute__((aligned(16))) unsigned char lds_raw[];
    LAS unsigned char* lds = (LAS unsigned char*)lds_raw;
    volatile LAS unsigned* MISC = (volatile LAS unsigned*)(lds + MISC_OFF);
    const int wave = __builtin_amdgcn_readfirstlane(threadIdx.x >> 6);
#define LANE_ID() ((int)__builtin_amdgcn_mbcnt_hi(~0u, __builtin_amdgcn_mbcnt_lo(~0u, 0u)))
    const int G = gridDim.x, bx = blockIdx.x, vcu = (G % 8 == 0) ? (bx % 8) * (G / 8) + bx / 8 : bx;
    unsigned char* ws = args.ws;
    gu32* ctl = (gu32*)(ws + WS_CTL);
    for (int u = threadIdx.x; u < (LDS_BYTES - LDSCTL_OFF) / 4; u += NWAVES * 64) ((LAS unsigned*)(lds + LDSCTL_OFF))[u] = 0u;
    __syncthreads();
    XcdBarrier bar = xcd_barrier_post((unsigned*)(ctl + CW_BAR) + args.li * XCD_BAR_WORDS, MISC + 8);
    const int lo = args.ph_lo, hi = args.ph_hi;
#ifndef PHMASK
#define PHMASK 0xffff
#endif
#define IN(k) (((PHMASK >> (k)) & 1) && lo <= (k) && (k) < hi)
#define SEAM(k) do { if (IN(k) && IN((k) + 1)) xcd_barrier(bar, wave); } while (0)
    const float* x = (const float*)args.in[0];
    float* out = args.out;
    float* ST0 = (float*)(ws + WS_ST0); float* SSQ = (float*)(ws + WS_SSQ); const float2* RT = (const float2*)(ws + WS_ROPE);
    bf16_t *PB = (bf16_t*)(ws + WS_PB), *XN = (bf16_t*)(ws + WS_XN), *Q = (bf16_t*)(ws + WS_Q), *KN = (bf16_t*)(ws + WS_KN), *V = (bf16_t*)(ws + WS_V), *PP = (bf16_t*)(ws + WS_PP),
           *FF = (bf16_t*)(ws + WS_FF), *GA = (bf16_t*)(ws + WS_GA), *GB = (bf16_t*)(ws + WS_GB), *MG = (bf16_t*)(ws + WS_MG), *AY = (bf16_t*)(ws + WS_AY), *U2 = (bf16_t*)(ws + WS_U2),
           *YG = (bf16_t*)(ws + WS_YG), *CQ = (bf16_t*)(ws + WS_CQ), *CKV = (bf16_t*)(ws + WS_CKV);
    bf16_t *WinT = (bf16_t*)(ws + WS_WIN), *WuqT = (bf16_t*)(ws + WS_WUQ), *WukvT = (bf16_t*)(ws + WS_WUKV), *WgluT = (bf16_t*)(ws + WS_WGLU), *WpleT = (bf16_t*)(ws + WS_WPLE),
           *WbrT = (bf16_t*)(ws + WS_WBR), *WoT = (bf16_t*)(ws + WS_WO), *WupT = (bf16_t*)(ws + WS_WUP), *WdownT = (bf16_t*)(ws + WS_WDOWN), *WpgT = (bf16_t*)(ws + WS_WPG);
    const int gw = vcu * NWAVES + wave, NGW = G * NWAVES;

    if (IN(PH_PRO)) {
        LAS float* scr = (LAS float*)(lds + RING_OFF + wave * 16384);
        const TrDesc descs[11] = {
            {(const float*)args.in[5], INW, DM, WinT, DM, 0, NIN_PAD, MAP_WIN, nullptr},
            {(const float*)args.in[8], NH * QHD, QL, WuqT, QL, 0, NH * QHD, MAP_WUQ, (const float*)args.in[7]},
            {(const float*)args.in[10], NH * 128, KVL, WukvT, KVL, 0, NH * 128, MAP_WUKV, (const float*)args.in[9]},
            {(const float*)args.in[20], SW, SW, WgluT, SW, 0, SW, MAP_P8, nullptr},
            {(const float*)args.in[32], DM, PLE, WpleT, PLE, 0, DM, MAP_P8, nullptr},
            {(const float*)args.in[11], DM, 512, WbrT, DM, 0, DM, MAP_P8, nullptr},
            {(const float*)args.in[22], DM, 512, WbrT, DM, 512, DM, MAP_P8, nullptr},
            {(const float*)args.in[23], DM, DM, WoT, DM, 0, DM, MAP_ID, nullptr},
            {(const float*)args.in[26], DFF, DM, WupT, DM, 0, DFF, MAP_P8, nullptr},
            {(const float*)args.in[27], DM, DFF, WdownT, DFF, 0, DM, MAP_ID, nullptr},
            {(const float*)args.in[30], DM, DM, WpgT, DM, 0, DM, MAP_ID, nullptr}};
        int base = 0;
#pragma unroll
        for (int d = 0; d < 11; ++d) { const int n = (descs[d].Ksrc / 64) * (descs[d].Ndst / 32);
            for (int it = gw; it < base + n; it += NGW) { if (it >= base) tr_item(descs[d], scr, it - base, LANE_ID()); }
            base += n; }
    }
    SEAM(PH_PRO);
    if (IN(PH_IN)) {
        pg8::Gemm g{XN, WinT, DM, NIN_PAD, DM, -1}; pg8::StaticOrder S; S.init(M, NIN_PAD, G, bx);
        pg8::EpiIn E{CQ, CKV, U2, GA, GB, SSQ, RT, (const float*)args.in[6]};
        pg8::gemm_phase<pg8::EpiIn, pg8::StaticOrder, true>(lds + RING_OFF, g, S, E, wave);
    }
    SEAM(PH_IN);
    if (IN(PH_QKV)) {
#ifndef NO_G2
        { pg8::Gemm g{CQ, WuqT, 512, NH * QHD, QL, -1}; pg8::StaticOrder S; S.init(M, NH * QHD, G, bx);
          pg8::EpiQ E{Q, SSQ, RT}; pg8::gemm_phase<pg8::EpiQ, pg8::StaticOrder, true>(lds + RING_OFF, g, S, E, wave); }
#endif
#ifndef NO_G3
        { pg8::Gemm g{CKV, WukvT, KVL, NH * 128, KVL, -1}; pg8::StaticOrder S; S.init(M, NH * 128, G, bx);
          pg8::EpiKV E{KN, V, SSQ}; pg8::gemm_phase<pg8::EpiKV, pg8::StaticOrder, true>(lds + RING_OFF, g, S, E, wave); }
#endif
    }
    SEAM(PH_QKV);
    SEAM(PH_MIX);
    if (IN(PH_GLU)) {
        { pg8::Gemm g{YG, WgluT, SW, SW, SW, -1}; pg8::StaticOrder S; S.init(M, SW, G, bx);
          pg8::EpiGluF E{YG, AY, (const float*)args.in[21]}; pg8::gemm_phase<pg8::EpiGluF, pg8::StaticOrder, true>(lds + RING_OFF, g, S, E, wave); }
        { pg8::Gemm g{PB, WpleT, PLE, DM, PLE, -1}; pg8::StaticOrder S; S.init(M, DM, G, bx);
          pg8::EpiStore<0> E{PP, DM}; pg8::gemm_phase<pg8::EpiStore<0>, pg8::StaticOrder, true>(lds + RING_OFF, g, S, E, wave); }
    }
    SEAM(PH_GLU);
    if (IN(PH_MERGE)) {
        pg8::Gemm g{AY, WbrT, DM, DM, DM, 8}; pg8::StaticOrder S; S.init(M, DM, G, bx);
        pg8::EpiMerge E{GA, GB, MG}; pg8::gemm_phase<pg8::EpiMerge, pg8::StaticOrder, true>(lds + RING_OFF, g, S, E, wave);
    }
    SEAM(PH_MERGE);
    if (IN(PH_WO)) {
        pg8::Gemm g{MG, WoT, DM, DM, DM, -1}; pg8::StaticOrder S; S.init(M, DM, G, bx);
        pg8::EpiPre<0> E{out, x, ST0, (const float*)args.in[3], (const float*)args.in[4], nullptr, nullptr};
        pg8::gemm_phase<pg8::EpiPre<0>, pg8::StaticOrder, true>(lds + RING_OFF, g, S, E, wave);
    }
    SEAM(PH_WO);
    if (IN(PH_LN1)) ln_rows(gw, NGW, LANE_ID(), out, XN, (const float*)args.in[24], (const float*)args.in[25]);
    SEAM(PH_LN1);
    if (IN(PH_UP)) {
        pg8::Gemm g{XN, WupT, DM, DFF, DM, -1}; pg8::StaticOrder S; S.init(M, DFF, G, bx);
        pg8::EpiStore<1> E{FF, DFF}; pg8::gemm_phase<pg8::EpiStore<1>, pg8::StaticOrder, true>(lds + RING_OFF, g, S, E, wave);
    }
    SEAM(PH_UP);
    if (IN(PH_DOWN)) {
        pg8::Gemm g{FF, WdownT, DFF, DM, DFF, -1}; pg8::StaticOrder S; S.init(M, DM, G, bx);
        pg8::EpiPre<1> E{out, nullptr, nullptr, nullptr, nullptr, nullptr, nullptr};
        pg8::gemm_phase<pg8::EpiPre<1>, pg8::StaticOrder, true>(lds + RING_OFF, g, S, E, wave);
    }
    SEAM(PH_DOWN);
    if (IN(PH_LN2)) ln_rows(gw, NGW, LANE_ID(), out, XN, (const float*)args.in[28], (const float*)args.in[29]);
    SEAM(PH_LN2);
    if (IN(PH_PLE)) {
        pg8::Gemm g{XN, WpgT, DM, DM, DM, -1}; pg8::StaticOrder S; S.init(M, DM, G, bx);
        pg8::EpiPre<2> E{out, nullptr, nullptr, nullptr, nullptr, PP, (const float*)args.in[31]};
        pg8::gemm_phase<pg8::EpiPre<2>, pg8::StaticOrder, true>(lds + RING_OFF, g, S, E, wave);
    }
    SEAM(PH_PLE);
    if (IN(PH_LN3)) ln_rows(gw, NGW, LANE_ID(), out, nullptr, (const float*)args.in[33], (const float*)args.in[34]);
#undef IN
#undef SEAM
}

template <class Epi> static void run_gemm(hipStream_t st, const bf16_t* A, int lda, const float* W, int ldw, const float* wscale, int N, int K, Epi e) {
    hipLaunchKernelGGL(ref_gemm<Epi>, dim3((N + 63) / 64, M / 64), dim3(256), 0, st, A, lda, W, ldw, wscale, N, K, e);
}
static int g_grid = 0;
static void launch_mk(hipStream_t st, Args a, int lo, int hi, int li) {
    a.ph_lo = lo; a.ph_hi = hi; a.li = li; a.pad = 0;
    hipLaunchKernelGGL(mk_fwd, dim3(g_grid), dim3(NWAVES * 64), LDS_BYTES, st, a);
    const hipError_t le = hipPeekAtLastError();
    if (le != hipSuccess) fprintf(stderr, "kernel_launch: mk_fwd launch failed: %s\n", hipGetErrorName(le));
}
extern "C" void kernel_launch(void* const* d_in, const int* in_sizes, int n_in, void* d_out, int out_size, void* d_ws, size_t ws_size, hipStream_t stream) {
    if (n_in != 35 || in_sizes[0] != M * DM || out_size != M * DM || ws_size < WS_END) { fprintf(stderr, "kernel_launch: unexpected shapes (n_in %d, in0 %d, out %d, ws %zu)\n", n_in, n_in > 0 ? in_sizes[0] : -1, out_size, ws_size); return; }
    if (g_grid == 0) {
        int dev = 0, cus = 0, per_cu = 0;
        if (hipGetDevice(&dev) != hipSuccess || hipDeviceGetAttribute(&cus, hipDeviceAttributeMultiprocessorCount, dev) != hipSuccess) { fprintf(stderr, "kernel_launch: device query failed\n"); g_grid = -1; return; }
        if (hipFuncSetAttribute((const void*)mk_fwd, hipFuncAttributeMaxDynamicSharedMemorySize, LDS_BYTES) != hipSuccess) { fprintf(stderr, "kernel_launch: hipFuncSetAttribute failed\n"); g_grid = -1; return; }
        if (hipOccupancyMaxActiveBlocksPerMultiprocessor(&per_cu, (const void*)mk_fwd, NWAVES * 64, LDS_BYTES) != hipSuccess || per_cu < 1) { fprintf(stderr, "kernel_launch: occupancy query says %d blocks per CU\n", per_cu); g_grid = -1; (void)hipGetLastError(); return; }
        (void)hipGetLastError();
        g_grid = cus;
        if (g_grid % 8 != 0 || g_grid <= 0) { fprintf(stderr, "kernel_launch: unexpected CU count %d\n", cus); }
    }
    if (g_grid < 0) return;
    const float* x = (const float*)d_in[0]; const float* p = (const float*)d_in[1]; const int* pos = (const int*)d_in[2];
    const float *ln_in_g = (const float*)d_in[3], *ln_in_b = (const float*)d_in[4], *a_re = (const float*)d_in[12],
                *a_im = (const float*)d_in[13], *log_dt = (const float*)d_in[14], *b_re = (const float*)d_in[15], *b_im = (const float*)d_in[16], *c_re = (const float*)d_in[17],
                *c_im = (const float*)d_in[18], *d_skip = (const float*)d_in[19];
    unsigned char* ws = (unsigned char*)d_ws; float* out = (float*)d_out;
    float* ST0 = (float*)(ws + WS_ST0); float2* RT = (float2*)(ws + WS_ROPE);
    bf16_t *PB = (bf16_t*)(ws + WS_PB), *XN = (bf16_t*)(ws + WS_XN), *Q = (bf16_t*)(ws + WS_Q), *KN = (bf16_t*)(ws + WS_KN), *V = (bf16_t*)(ws + WS_V),
           *AY = (bf16_t*)(ws + WS_AY), *U2 = (bf16_t*)(ws + WS_U2), *YG = (bf16_t*)(ws + WS_YG), *CQ = (bf16_t*)(ws + WS_CQ);
    (void)hipMemsetAsync(ws + WS_CTL, 0, CTL_ZERO_BYTES, stream);
    Args a{};
    for (int i = 0; i < 35; ++i) a.in[i] = d_in[i];
    a.out = out; a.ws = ws;
    hipLaunchKernelGGL(k_ln, dim3(M / 4), dim3(256), 0, stream, x, (float*)nullptr, XN, ST0, ln_in_g, ln_in_b);
    hipLaunchKernelGGL(k_to_bf16, dim3(2048), dim3(256), 0, stream, p, PB, (size_t)M * PLE / 4);
    hipLaunchKernelGGL(k_rope_tab, dim3(M * 16 / 256), dim3(256), 0, stream, pos, RT);
    launch_mk(stream, a, PH_PRO, PH_MIX, 0);
    hipLaunchKernelGGL(ref_attn, dim3(SEQ / 64, NH, NB), dim3(64), 0, stream, Q, KN, CQ, V, AY);
    hipLaunchKernelGGL(ref_s5, dim3(NG, NB), dim3(64), 0, stream, U2, a_re, a_im, log_dt, b_re, b_im, c_re, c_im, d_skip, YG);
    launch_mk(stream, a, PH_GLU, PH_END, 1);
}
```

```cpp
#include <hip/hip_runtime.h>
#include <cstdio>
#include <cstdint>

typedef unsigned short bf16_t;

constexpr int NB = 8, SEQ = 4096, DM = 1024, M = NB * SEQ;
constexpr int PLE = 256, NH = 8, NOPE = 64, ROPE = 32, VD = 64, QHD = NOPE + ROPE, QL = 384, KVL = 256;
constexpr int SW = 512, SG = 16, NG = 32, SP = 64, DFF = 4096;
constexpr int INW = QL + KVL + ROPE + SW + DM + DM;
constexpr int OFF_CQ = 0, OFF_CKV = QL, OFF_KR = QL + KVL, OFF_U = OFF_KR + ROPE, OFF_GA = OFF_U + SW, OFF_GB = OFF_GA + DM;
constexpr float LN_EPS = 1e-5f, RMS_EPS = 1e-6f;
constexpr float ALPHA = 1.189207115002721f;
constexpr float QSCALE = 0.10206207261596575f * 1.4426950408889634f;

constexpr size_t MiB = 1u << 20;
constexpr size_t WS_CTL = 0;
constexpr size_t WS_ST0 = 34 * MiB;
constexpr size_t WS_RS = WS_ST0 + 512 * 1024;
constexpr size_t WS_ROPE = 37 * MiB;
constexpr size_t WS_PB = 50 * MiB;
constexpr size_t WS_XN = 66 * MiB;
constexpr size_t WS_Q = WS_XN;
constexpr size_t WS_KN = 130 * MiB, WS_V = 162 * MiB;
constexpr size_t WS_PP = 130 * MiB;
constexpr size_t WS_FF = 194 * MiB;
constexpr size_t WS_GA = 194 * MiB, WS_GB = 258 * MiB;
constexpr size_t WS_MG = WS_GA;
constexpr size_t WS_AY = 322 * MiB;
constexpr size_t WS_U2 = 386 * MiB;
constexpr size_t WS_YG = 418 * MiB;
constexpr size_t WS_CQ = 450 * MiB;
constexpr size_t WS_CKV = 482 * MiB;
constexpr size_t WS_KRRAW = 498 * MiB;
constexpr size_t WS_END = 502 * MiB;

__device__ __forceinline__ float bf2f(unsigned v) { return __uint_as_float(v << 16); }
__device__ __forceinline__ bf16_t f2bf(float f) { unsigned u = __float_as_uint(f); return (bf16_t)((u + 0x7fffu + ((u >> 16) & 1u)) >> 16); }
__device__ __forceinline__ float sigmoidf_(float v) { return 1.0f / (1.0f + __expf(-v)); }
__device__ __forceinline__ float gelu_tanh(float v) { const float z = 0.7978845608028654f * (v + 0.044715f * v * v * v); const float e = __expf(2.0f * z); return 0.5f * v * (2.0f - 2.0f / (1.0f + e)); }
__device__ __forceinline__ void sincos_d(double a, double& s, double& c) {
    const double k = __builtin_rint(a * 0.6366197723675814);
    double r = __builtin_fma(-k, 1.5707963267948966, a); r = __builtin_fma(-k, 6.123233995736766e-17, r);
    const double r2 = r * r;
    double sp = -7.647163731819816e-13; sp = sp * r2 + 1.6059043836821613e-10; sp = sp * r2 - 2.505210838544172e-08; sp = sp * r2 + 2.7557319223985893e-06;
    sp = sp * r2 - 0.0001984126984126984; sp = sp * r2 + 0.008333333333333333; sp = sp * r2 - 0.16666666666666666; sp = r + r * r2 * sp;
    double cp = 4.779477332387385e-14; cp = cp * r2 - 1.1470745597729725e-11; cp = cp * r2 + 2.08767569878681e-09; cp = cp * r2 - 2.755731922398589e-07;
    cp = cp * r2 + 2.48015873015873e-05; cp = cp * r2 - 0.001388888888888889; cp = cp * r2 + 0.041666666666666664; cp = cp * r2 - 0.5; cp = 1.0 + r2 * cp;
    const int q = ((int)k) & 3;
    s = (q == 0) ? sp : (q == 1) ? cp : (q == 2) ? -sp : -cp;
    c = (q == 0) ? cp : (q == 1) ? -sp : (q == 2) ? -cp : sp;
}
__device__ __forceinline__ double exp_small_d(double x) {
    double p = 1.0 / 3628800.0; p = p * x + 1.0 / 362880.0; p = p * x + 1.0 / 40320.0; p = p * x + 1.0 / 5040.0; p = p * x + 1.0 / 720.0; p = p * x + 1.0 / 120.0;
    p = p * x + 1.0 / 24.0; p = p * x + 1.0 / 6.0; p = p * x + 0.5; p = p * x + 1.0; p = p * x + 1.0; return p;
}
__constant__ float c_inv_freq[16] = {1.0f, 0.5623413251903491f, 0.31622776601683794f, 0.1778279410038923f, 0.1f, 0.05623413251903491f, 0.03162277660168379f, 0.01778279410038923f,
                                     0.01f, 0.005623413251903491f, 0.003162277660168379f, 0.001778279410038923f, 0.001f, 0.0005623413251903491f, 0.00031622776601683794f, 0.0001778279410038923f};

__global__ void __launch_bounds__(256) k_ln(const float* in, float* out_f, bf16_t* out_b, float* stats, const float* __restrict__ g, const float* __restrict__ b) {
    const int lane = threadIdx.x & 63, row = blockIdx.x * 4 + (threadIdx.x >> 6);
    const float4* xr = (const float4*)(in + (size_t)row * DM) + lane;
    float4 v[4]; float s = 0.f;
#pragma unroll
    for (int j = 0; j < 4; ++j) { v[j] = xr[64 * j]; s += (v[j].x + v[j].y) + (v[j].z + v[j].w); }
#pragma unroll
    for (int o = 1; o < 64; o <<= 1) s += __shfl_xor(s, o);
    const float mean = s * (1.f / DM); float s2 = 0.f;
#pragma unroll
    for (int j = 0; j < 4; ++j) { v[j].x -= mean; v[j].y -= mean; v[j].z -= mean; v[j].w -= mean; s2 += (v[j].x * v[j].x + v[j].y * v[j].y) + (v[j].z * v[j].z + v[j].w * v[j].w); }
#pragma unroll
    for (int o = 1; o < 64; o <<= 1) s2 += __shfl_xor(s2, o);
    const float rstd = 1.0f / sqrtf(s2 * (1.f / DM) + LN_EPS);
    if (stats && lane == 0) { stats[2 * row] = mean; stats[2 * row + 1] = rstd; }
#pragma unroll
    for (int j = 0; j < 4; ++j) {
        const float4 gg = ((const float4*)g)[lane + 64 * j], bb = ((const float4*)b)[lane + 64 * j];
        float4 o; o.x = v[j].x * rstd * gg.x + bb.x; o.y = v[j].y * rstd * gg.y + bb.y; o.z = v[j].z * rstd * gg.z + bb.z; o.w = v[j].w * rstd * gg.w + bb.w;
        if (out_f) ((float4*)(out_f + (size_t)row * DM))[lane + 64 * j] = o;
        if (out_b) { uint2 w; w.x = (unsigned)f2bf(o.x) | ((unsigned)f2bf(o.y) << 16); w.y = (unsigned)f2bf(o.z) | ((unsigned)f2bf(o.w) << 16); ((uint2*)(out_b + (size_t)row * DM))[lane + 64 * j] = w; }
    }
}
__global__ void __launch_bounds__(256) k_to_bf16(const float* __restrict__ in, bf16_t* __restrict__ out, size_t n4) {
    for (size_t i = (size_t)blockIdx.x * 256 + threadIdx.x; i < n4; i += (size_t)gridDim.x * 256) {
        const float4 v = ((const float4*)in)[i]; uint2 w; w.x = (unsigned)f2bf(v.x) | ((unsigned)f2bf(v.y) << 16); w.y = (unsigned)f2bf(v.z) | ((unsigned)f2bf(v.w) << 16); ((uint2*)out)[i] = w; }
}
__global__ void __launch_bounds__(256) k_rope_tab(const int* __restrict__ pos, float2* __restrict__ tab) {
    const int idx = blockIdx.x * 256 + threadIdx.x; if (idx >= M * 16) return;
    const int r = idx >> 4, i = idx & 15;
    const float ang = (float)pos[r] * c_inv_freq[i];
    double s, c; sincos_d((double)ang, s, c);
    tab[idx] = make_float2((float)c, (float)s);
}
__global__ void __launch_bounds__(256) k_rms_stats(const bf16_t* __restrict__ CQ, const bf16_t* __restrict__ CKV, float* __restrict__ RS) {
    const int lane = threadIdx.x & 63, row = blockIdx.x * 4 + (threadIdx.x >> 6);
    float sq = 0.f, sk = 0.f;
    for (int c = lane; c < QL; c += 64) { const float v = bf2f(CQ[(size_t)row * 512 + c]); sq += v * v; }
    for (int c = lane; c < KVL; c += 64) { const float v = bf2f(CKV[(size_t)row * 256 + c]); sk += v * v; }
#pragma unroll
    for (int o = 1; o < 64; o <<= 1) { sq += __shfl_xor(sq, o); sk += __shfl_xor(sk, o); }
    if (lane == 0) { RS[2 * row] = 1.0f / sqrtf(sq * (1.f / QL) + RMS_EPS); RS[2 * row + 1] = 1.0f / sqrtf(sk * (1.f / KVL) + RMS_EPS); }
}
__global__ void __launch_bounds__(256) k_rope_k(const float* __restrict__ KR, const float2* __restrict__ tab, bf16_t* __restrict__ CQ) {
    const int idx = blockIdx.x * 256 + threadIdx.x; if (idx >= M * 32) return;
    const int r = idx >> 5, c = idx & 31, i = c & 15; const float2 cs = tab[r * 16 + i];
    const float x1 = KR[r * 32 + i], x2 = KR[r * 32 + 16 + i];
    const float o = (c < 16) ? (x1 * cs.x - x2 * cs.y) : (x2 * cs.x + x1 * cs.y);
    CQ[(size_t)r * 512 + QL + c] = f2bf(o);
}
__global__ void __launch_bounds__(256) k_rope_q(const float* __restrict__ Qraw, const float2* __restrict__ tab, bf16_t* __restrict__ Q) {
    const size_t idx = (size_t)blockIdx.x * 256 + threadIdx.x; if (idx >= (size_t)M * 768) return;
    const int r = (int)(idx / 768), c = (int)(idx % 768), d = c % QHD;
    float o;
    if (d < NOPE) o = Qraw[idx];
    else { const int j = d - NOPE, i = j & 15; const float2 cs = tab[r * 16 + i];
        const size_t b0 = idx - j; const float x1 = Qraw[b0 + i], x2 = Qraw[b0 + 16 + i];
        o = (j < 16) ? (x1 * cs.x - x2 * cs.y) : (x2 * cs.x + x1 * cs.y); }
    Q[idx] = f2bf(o * QSCALE);
}

template <class Epi>
__global__ void __launch_bounds__(256) ref_gemm(const bf16_t* __restrict__ A, int lda, const float* __restrict__ W, int ldw, const float* __restrict__ wscale, int N, int K, Epi epi) {
    __shared__ float As[16][68];
    __shared__ float Ws[16][68];
    const int tid = threadIdx.x, tx = tid & 15, ty = tid >> 4;
    const int m0 = blockIdx.y * 64, n0 = blockIdx.x * 64;
    float acc[4][4];
#pragma unroll
    for (int i = 0; i < 4; ++i)
#pragma unroll
        for (int j = 0; j < 4; ++j) acc[i][j] = 0.f;
    for (int k0 = 0; k0 < K; k0 += 16) {
        { const int r = tid >> 2, kk = (tid & 3) * 4; const uint2 v = *(const uint2*)(A + (size_t)(m0 + r) * lda + k0 + kk);
          As[kk + 0][r] = bf2f(v.x & 0xffffu); As[kk + 1][r] = bf2f(v.x >> 16); As[kk + 2][r] = bf2f(v.y & 0xffffu); As[kk + 3][r] = bf2f(v.y >> 16); }
        { const int kk = tid >> 4, nn = (tid & 15) * 4; const float sc = wscale ? wscale[k0 + kk] : 1.f;
#pragma unroll
          for (int j = 0; j < 4; ++j) { const int n = n0 + nn + j; const float w = (n < N) ? W[(size_t)(k0 + kk) * ldw + n] * sc : 0.f; Ws[kk][nn + j] = bf2f((unsigned)f2bf(w)); } }
        __syncthreads();
#pragma unroll
        for (int kk = 0; kk < 16; ++kk) {
            const float4 a = *(const float4*)&As[kk][ty * 4]; const float4 b = *(const float4*)&Ws[kk][tx * 4];
            acc[0][0] += a.x * b.x; acc[0][1] += a.x * b.y; acc[0][2] += a.x * b.z; acc[0][3] += a.x * b.w;
            acc[1][0] += a.y * b.x; acc[1][1] += a.y * b.y; acc[1][2] += a.y * b.z; acc[1][3] += a.y * b.w;
            acc[2][0] += a.z * b.x; acc[2][1] += a.z * b.y; acc[2][2] += a.z * b.z; acc[2][3] += a.z * b.w;
            acc[3][0] += a.w * b.x; acc[3][1] += a.w * b.y; acc[3][2] += a.w * b.z; acc[3][3] += a.w * b.w;
        }
        __syncthreads();
    }
#pragma unroll
    for (int i = 0; i < 4; ++i)
#pragma unroll
        for (int j = 0; j < 4; ++j) { const int row = m0 + ty * 4 + i, col = n0 + tx * 4 + j; if (col < N) epi(row, col, acc[i][j]); }
}
struct EpiCq { bf16_t* CQ; __device__ void operator()(int r, int c, float v) const { CQ[(size_t)r * 512 + c] = f2bf(v); } };
struct EpiCkv { bf16_t* CKV; __device__ void operator()(int r, int c, float v) const { CKV[(size_t)r * 256 + c] = f2bf(v); } };
struct EpiKr { float* KR; __device__ void operator()(int r, int c, float v) const { KR[(size_t)r * 32 + c] = v; } };
struct EpiU { bf16_t* U2; __device__ void operator()(int r, int c, float v) const { const int b = r / SEQ, t = r % SEQ, g = c >> 4, n = c & 15; U2[(((size_t)b * NG + g) * SEQ + t) * 16 + n] = f2bf(v); } };
struct EpiGate { bf16_t* G; const float* bias; __device__ void operator()(int r, int c, float v) const { G[(size_t)r * DM + c] = f2bf(sigmoidf_(v + bias[c])); } };
struct EpiQraw { float* Qraw; const float* RS; __device__ void operator()(int r, int c, float v) const { Qraw[(size_t)r * 768 + c] = v * RS[2 * r]; } };
struct EpiKv { bf16_t* KN; bf16_t* V; const float* RS; __device__ void operator()(int r, int c, float v) const { v *= RS[2 * r + 1]; const int h = c >> 7, d = c & 127;
    if (d < 64) KN[(size_t)r * 512 + 64 * h + d] = f2bf(v); else V[(size_t)r * 512 + 64 * h + d - 64] = f2bf(v); } };
struct EpiGlu { const bf16_t* YG; bf16_t* AY; const float* b; __device__ void operator()(int r, int c, float v) const { const float y = bf2f(YG[(size_t)r * 512 + c]); AY[(size_t)r * DM + 512 + c] = f2bf(y * sigmoidf_(v + b[c])); } };
struct EpiPP { bf16_t* PP; __device__ void operator()(int r, int c, float v) const { PP[(size_t)r * DM + c] = f2bf(v); } };
struct EpiBrA { const bf16_t* GA; float* T1; __device__ void operator()(int r, int c, float v) const { T1[(size_t)r * DM + c] = bf2f(GA[(size_t)r * DM + c]) * v; } };
struct EpiBrB { const bf16_t* GB; const float* T1; bf16_t* MG; __device__ void operator()(int r, int c, float v) const { MG[(size_t)r * DM + c] = f2bf(T1[(size_t)r * DM + c] + bf2f(GB[(size_t)r * DM + c]) * v); } };
struct EpiWo { const float* x; const float* ST0; const float* g; const float* b; float* out;
    __device__ void operator()(int r, int c, float v) const { const float h0 = (x[(size_t)r * DM + c] - ST0[2 * r]) * ST0[2 * r + 1] * g[c] + b[c]; out[(size_t)r * DM + c] = ALPHA * h0 + v; } };
struct EpiUp { bf16_t* FF; __device__ void operator()(int r, int c, float v) const { const float t = fmaxf(v, 0.f); FF[(size_t)r * DFF + c] = f2bf(t * t); } };
struct EpiDown { float* out; __device__ void operator()(int r, int c, float v) const { out[(size_t)r * DM + c] = ALPHA * out[(size_t)r * DM + c] + v; } };
struct EpiPle { float* out; const bf16_t* PP; const float* b; __device__ void operator()(int r, int c, float v) const { out[(size_t)r * DM + c] = ALPHA * out[(size_t)r * DM + c] + sigmoidf_(v + b[c]) * bf2f(PP[(size_t)r * DM + c]); } };

__global__ void __launch_bounds__(64) ref_attn(const bf16_t* __restrict__ Q, const bf16_t* __restrict__ KN, const bf16_t* __restrict__ CQ, const bf16_t* __restrict__ V, bf16_t* __restrict__ AY) {
    __shared__ float Ks[64][97];
    __shared__ float Vs[64][65];
    const int qt = blockIdx.x, h = blockIdx.y, b = blockIdx.z, tid = threadIdx.x;
    const size_t qrow = (size_t)b * SEQ + qt * 64 + tid;
    float q[QHD], o[VD];
#pragma unroll
    for (int d = 0; d < QHD; ++d) q[d] = bf2f(Q[qrow * 768 + h * QHD + d]);
#pragma unroll
    for (int d = 0; d < VD; ++d) o[d] = 0.f;
    float m = -1e30f, l = 0.f;
    for (int kt = 0; kt <= qt; ++kt) {
        __syncthreads();
        { const size_t krow = (size_t)b * SEQ + kt * 64 + tid;
          for (int d = 0; d < NOPE; ++d) Ks[tid][d] = bf2f(KN[krow * 512 + h * 64 + d]);
          for (int d = 0; d < ROPE; ++d) Ks[tid][NOPE + d] = bf2f(CQ[krow * 512 + QL + d]);
          for (int d = 0; d < VD; ++d) Vs[tid][d] = bf2f(V[krow * 512 + h * 64 + d]); }
        __syncthreads();
        for (int j = 0; j < 64; ++j) {
            if (kt < qt || j <= tid) {
                float s = 0.f;
#pragma unroll
                for (int d = 0; d < QHD; ++d) s += q[d] * Ks[j][d];
                if (s > m) { const float sc = exp2f(m - s); l *= sc;
#pragma unroll
                    for (int d = 0; d < VD; ++d) o[d] *= sc;
                    m = s; }
                const float p = exp2f(s - m); l += p;
#pragma unroll
                for (int d = 0; d < VD; ++d) o[d] += p * Vs[j][d];
            }
        }
    }
    const float rl = 1.0f / l;
#pragma unroll
    for (int d = 0; d < VD; ++d) AY[qrow * DM + h * VD + d] = f2bf(o[d] * rl);
}

__global__ void __launch_bounds__(64) ref_s5(const bf16_t* __restrict__ U2, const float* __restrict__ a_re, const float* __restrict__ a_im, const float* __restrict__ log_dt,
                                             const float* __restrict__ b_re, const float* __restrict__ b_im, const float* __restrict__ c_re, const float* __restrict__ c_im,
                                             const float* __restrict__ d_skip, bf16_t* __restrict__ YG) {
    __shared__ float us[64][17];
    __shared__ float xs[64][129];
    __shared__ float Cm[128][16];
    const int g = blockIdx.x, b = blockIdx.y, p = threadIdx.x;
    float ar, ai, bbr[16], bbi[16];
    {
        const double dt = (double)__expf(log_dt[g]);
        const double lr = (double)fminf(a_re[g * SP + p], -1e-4f), li = (double)a_im[g * SP + p];
        const double mag = exp_small_d(lr * dt); double sn, cs; sincos_d(li * dt, sn, cs);
        const double abr = mag * cs, abi = mag * sn;
        const double den = lr * lr + li * li, nr = abr - 1.0, ni = abi;
        const double fr = (nr * lr + ni * li) / den, fi = (ni * lr - nr * li) / den;
        ar = (float)abr; ai = (float)abi;
#pragma unroll
        for (int n = 0; n < 16; ++n) { const double br = (double)b_re[((size_t)g * SP + p) * SG + n], bi = (double)b_im[((size_t)g * SP + p) * SG + n];
            bbr[n] = (float)(fr * br - fi * bi); bbi[n] = (float)(fr * bi + fi * br); }
        for (int n = 0; n < 16; ++n) { Cm[p][n] = c_re[((size_t)g * SG + n) * SP + p]; Cm[64 + p][n] = -c_im[((size_t)g * SG + n) * SP + p]; }
    }
    float dsk[16];
#pragma unroll
    for (int n = 0; n < 16; ++n) dsk[n] = d_skip[g * SG + n];
    float xr = 0.f, xi = 0.f;
    const bf16_t* ub = U2 + ((size_t)b * NG + g) * SEQ * 16;
    for (int t0 = 0; t0 < SEQ; t0 += 64) {
        __syncthreads();
        for (int n = 0; n < 16; ++n) us[p][n] = bf2f(ub[(size_t)(t0 + p) * 16 + n]);
        __syncthreads();
        for (int tt = 0; tt < 64; ++tt) {
            float br = 0.f, bi = 0.f;
#pragma unroll
            for (int n = 0; n < 16; ++n) { const float uv = us[tt][n]; br += bbr[n] * uv; bi += bbi[n] * uv; }
            const float nr = ar * xr - ai * xi + br, ni = ar * xi + ai * xr + bi; xr = nr; xi = ni;
            xs[tt][p] = xr; xs[tt][64 + p] = xi;
        }
        __syncthreads();
        float y[16];
#pragma unroll
        for (int n = 0; n < 16; ++n) y[n] = dsk[n] * us[p][n];
        for (int k = 0; k < 128; ++k) { const float xv = xs[p][k];
#pragma unroll
            for (int n = 0; n < 16; ++n) y[n] += xv * Cm[k][n]; }
        bf16_t* yo = YG + ((size_t)b * SEQ + t0 + p) * SW + g * SG;
#pragma unroll
        for (int n = 0; n < 16; ++n) yo[n] = f2bf(gelu_tanh(y[n]));
    }
}

constexpr size_t WS_WIN = 2 * MiB;
constexpr int NIN_PAD = 3328;
constexpr size_t WS_WUQ = WS_WIN + (size_t)NIN_PAD * DM * 2;
constexpr size_t WS_WUKV = WS_WUQ + (size_t)768 * QL * 2;
constexpr size_t WS_WGLU = WS_WUKV + (size_t)1024 * KVL * 2;
constexpr size_t WS_WPLE = WS_WGLU + (size_t)SW * SW * 2;
constexpr size_t WS_WBR = WS_WPLE + (size_t)DM * PLE * 2;
constexpr size_t WS_WO = WS_WBR + (size_t)DM * DM * 2;
constexpr size_t WS_WUP = WS_WO + (size_t)DM * DM * 2;
constexpr size_t WS_WDOWN = WS_WUP + (size_t)DFF * DM * 2;
constexpr size_t WS_WPG = WS_WDOWN + (size_t)DM * DFF * 2;
constexpr size_t WS_WEND = WS_WPG + (size_t)DM * DM * 2;
static_assert(WS_WEND <= WS_ST0, "weights fit below ST0");
constexpr size_t WS_SSQ = 35 * MiB;
static_assert(WS_SSQ + (size_t)M * 16 * 4 <= WS_ROPE, "ssq region");
constexpr size_t CTL_ZERO_BYTES = 1 * MiB;

namespace pg8 {
#define PG8_LAS __attribute__((address_space(3)))
typedef short bf16x8 __attribute__((ext_vector_type(8)));
typedef float f32x4 __attribute__((ext_vector_type(4)));
typedef float f32x2 __attribute__((ext_vector_type(2)));
typedef unsigned u32x4 __attribute__((ext_vector_type(4)));
typedef unsigned u32x2 __attribute__((ext_vector_type(2)));
constexpr int BM = 256, BK = 64, HALF = 128, HTB = HALF * BK * 2, STAGE_BYTES = 8 * HTB, NXCD = 8, WGM = 8;

__host__ __device__ __forceinline__ int lds_byte(int r, int c) { const int st = (r >> 4) * 2 + (c >> 5), rr = r & 15, cc = c & 31, ob = rr * 64 + cc * 2; return st * 1024 + (ob ^ (((ob >> 9) & 1) << 5)); }
__host__ __device__ __forceinline__ void stage_rc(int b, int& R, int& C) { const int st = b / 1024, sb = b % 1024, swz = sb ^ (((sb >> 9) & 1) << 5); R = (st >> 1) * 16 + swz / 64; C = (st & 1) * 32 + (swz % 64) / 2; }

struct Unit { int pm, pn; };
struct Gemm { const bf16_t* A; const bf16_t* Bt; int lda; int N, K; int tmid; };

struct StaticOrder {
    int nM, nN, nwg, G, c, i0, i1;
    __host__ __device__ void init(int Mrows, int N, int G_, int c_, int i0_ = 0, int i1_ = 1 << 20) { nM = Mrows / BM; nN = N / BM; nwg = nM * nN; G = G_; c = c_; i0 = i0_; i1 = i1_; }
    __host__ __device__ bool next(int i, Unit& u) const {
        i += i0; if (i >= i1) return false;
        const long L = (long)i * G + c; if (L >= nwg) return false;
        int wgid = (int)L; { const int q = nwg / NXCD, r = nwg % NXCD, xcd = wgid % NXCD, off = wgid / NXCD; wgid = (xcd < r ? xcd * (q + 1) : r * (q + 1) + (xcd - r) * q) + off; }
        const int nig = WGM * nN, gid = wgid / nig, fm = gid * WGM, gsz = (nM - fm) < WGM ? (nM - fm) : WGM;
        u.pm = fm + ((wgid % nig) % gsz); u.pn = (wgid % nig) / gsz; return true;
    }
};

__device__ __forceinline__ unsigned cvt_pk_bf16(float lo, float hi) { unsigned r; asm volatile("v_cvt_pk_bf16_f32 %0, %1, %2" : "=v"(r) : "v"(lo), "v"(hi)); return r; }
__device__ __forceinline__ u32x4 pack8(const f32x4 a, const f32x4 b) { u32x4 w; w.x = cvt_pk_bf16(a[0], a[1]); w.y = cvt_pk_bf16(a[2], a[3]); w.z = cvt_pk_bf16(b[0], b[1]); w.w = cvt_pk_bf16(b[2], b[3]); return w; }
__device__ __forceinline__ u32x2 pack4(const f32x4 a) { u32x2 w; w.x = cvt_pk_bf16(a[0], a[1]); w.y = cvt_pk_bf16(a[2], a[3]); return w; }
__device__ __forceinline__ float fsig(float v) { return __builtin_amdgcn_rcpf(1.0f + __builtin_amdgcn_exp2f(-1.4426950408889634f * v)); }
__device__ __forceinline__ f32x4 fsig4(f32x4 v) { f32x4 o; o[0] = fsig(v[0]); o[1] = fsig(v[1]); o[2] = fsig(v[2]); o[3] = fsig(v[3]); return o; }
__device__ __forceinline__ f32x4 bf4_to_f32(u32x2 w) { f32x4 o; o[0] = __uint_as_float(w.x << 16); o[1] = __uint_as_float(w.x & 0xffff0000u); o[2] = __uint_as_float(w.y << 16); o[3] = __uint_as_float(w.y & 0xffff0000u); return o; }

typedef f32x4 Acc[2][2][4][2];

struct EpiIn {
    static constexpr bool AFTER_DRAIN = false, HAS_MID = false;
    bf16_t *CQ, *CKV, *U2, *GA, *GB; float* SSQ; const float2* RT; const float* bgate;
    __device__ __forceinline__ void mid(Acc&, const Unit&, int, int, int, int) const {}
    __device__ __forceinline__ void operator()(const Acc& acc, const Unit& u, int wr, int wc, int fr, int fq) const {
        const int pn = u.pn, row0 = u.pm * BM + wr * 64 + fr;
        if (pn <= 2) {
#pragma unroll
            for (int ai = 0; ai < 2; ++ai)
#pragma unroll
                for (int m = 0; m < 4; ++m) { const int row = row0 + ai * HALF + m * 16; float ss = 0.f;
#pragma unroll
                    for (int bj = 0; bj < 2; ++bj) { const f32x4 v0 = acc[ai][bj][m][0], v1 = acc[ai][bj][m][1];
                        if (pn == 1 && bj == 1) {
                            if (wc == 0) {
                                const f32x4 t0 = *(const f32x4*)((const float*)RT + ((size_t)row * 16 + 4 * fq) * 2), t1 = *(const f32x4*)((const float*)RT + ((size_t)row * 16 + 4 * fq) * 2 + 4);
                                const f32x4 cs = {t0[0], t0[2], t1[0], t1[2]}, sn = {t0[1], t0[3], t1[1], t1[3]};
                                const f32x4 o1 = v0 * cs - v1 * sn, o2 = v1 * cs + v0 * sn;
                                *(u32x2*)(CQ + (size_t)row * 512 + QL + 4 * fq) = pack4(o1); *(u32x2*)(CQ + (size_t)row * 512 + QL + 16 + 4 * fq) = pack4(o2);
                            }
                        } else {
                            ss += (v0[0] * v0[0] + v0[1] * v0[1]) + (v0[2] * v0[2] + v0[3] * v0[3]) + (v1[0] * v1[0] + v1[1] * v1[1]) + (v1[2] * v1[2] + v1[3] * v1[3]);
                            bf16_t* dst = (pn < 2) ? CQ + (size_t)row * 512 + 256 * pn + 128 * bj + 32 * wc + 8 * fq : CKV + (size_t)row * 256 + 128 * bj + 32 * wc + 8 * fq;
                            *(u32x4*)dst = pack8(v0, v1);
                        } }
                    ss += __shfl_xor(ss, 16); ss += __shfl_xor(ss, 32);
                    if (fq == 0) SSQ[(size_t)row * 16 + 4 * pn + wc] = ss; asm volatile("" ::: "memory"); }
        } else if (pn <= 4) {
#pragma unroll
            for (int ai = 0; ai < 2; ++ai)
#pragma unroll
                for (int m = 0; m < 4; ++m) { const int row = row0 + ai * HALF + m * 16, b = row / SEQ, t = row % SEQ;
#pragma unroll
                    for (int bj = 0; bj < 2; ++bj) { const int c = 256 * (pn - 3) + 128 * bj + 32 * wc + 8 * fq, g = c >> 4, n0 = c & 15;
                        *(u32x4*)(U2 + (((size_t)b * NG + g) * SEQ + t) * 16 + n0) = pack8(acc[ai][bj][m][0], acc[ai][bj][m][1]); } }
        } else {
            const int gi = pn - 5; bf16_t* G = (gi < 4) ? GA : GB; const float* bia = bgate + ((gi < 4) ? 0 : DM);
#pragma unroll
            for (int bj = 0; bj < 2; ++bj) { const int c = 256 * (gi & 3) + 128 * bj + 32 * wc + 8 * fq; const f32x4 b0 = *(const f32x4*)(bia + c), b1 = *(const f32x4*)(bia + c + 4);
#pragma unroll
                for (int ai = 0; ai < 2; ++ai)
#pragma unroll
                    for (int m = 0; m < 4; ++m) { const int row = row0 + ai * HALF + m * 16;
                        *(u32x4*)(G + (size_t)row * DM + c) = pack8(fsig4(acc[ai][bj][m][0] + b0), fsig4(acc[ai][bj][m][1] + b1)); } }
        }
    }
};
struct EpiQ {
    static constexpr bool AFTER_DRAIN = false, HAS_MID = false;
    bf16_t* Q; const float* SSQ; const float2* RT;
    __device__ __forceinline__ void mid(Acc&, const Unit&, int, int, int, int) const {}
    __device__ __forceinline__ void operator()(const Acc& acc, const Unit& u, int wr, int wc, int fr, int fq) const {
        const int row0 = u.pm * BM + wr * 64 + fr;
        float rs[2][4];
#pragma unroll
        for (int ai = 0; ai < 2; ++ai)
#pragma unroll
            for (int m = 0; m < 4; ++m) { const float* sp = SSQ + (size_t)(row0 + ai * HALF + m * 16) * 16; const f32x4 s0 = *(const f32x4*)sp, s1 = *(const f32x4*)(sp + 4);
                rs[ai][m] = QSCALE * __builtin_amdgcn_rsqf(((s0[0] + s0[1]) + (s0[2] + s0[3]) + (s1[0] + s1[1]) + (s1[2] + s1[3])) * (1.0f / QL) + RMS_EPS); }
        asm volatile("" ::: "memory");
#pragma unroll
        for (int bj = 0; bj < 2; ++bj) { const int grp = 8 * u.pn + 4 * bj + wc;
            if (grp % 3 == 2) {
#pragma unroll
                for (int ai = 0; ai < 2; ++ai)
#pragma unroll
                    for (int m = 0; m < 4; ++m) { const int row = row0 + ai * HALF + m * 16; const float* tp = (const float*)RT + ((size_t)row * 16 + 4 * fq) * 2;
                        const f32x4 t0 = *(const f32x4*)tp, t1 = *(const f32x4*)(tp + 4);
                        const f32x4 cs = {t0[0], t0[2], t1[0], t1[2]}, sn = {t0[1], t0[3], t1[1], t1[3]};
                        const f32x4 v0 = acc[ai][bj][m][0] * rs[ai][m], v1 = acc[ai][bj][m][1] * rs[ai][m];
                        const f32x4 o1 = v0 * cs - v1 * sn, o2 = v1 * cs + v0 * sn; bf16_t* qp = Q + (size_t)row * 768 + 32 * grp + 4 * fq;
                        *(u32x2*)qp = pack4(o1); *(u32x2*)(qp + 16) = pack4(o2); asm volatile("" ::: "memory"); }
            } else {
#pragma unroll
                for (int ai = 0; ai < 2; ++ai)
#pragma unroll
                    for (int m = 0; m < 4; ++m) { const int row = row0 + ai * HALF + m * 16;
                        *(u32x4*)(Q + (size_t)row * 768 + 32 * grp + 8 * fq) = pack8(acc[ai][bj][m][0] * rs[ai][m], acc[ai][bj][m][1] * rs[ai][m]); }
            } }
    }
};
struct EpiKV {
    static constexpr bool AFTER_DRAIN = false, HAS_MID = false;
    bf16_t *KN, *V; const float* SSQ;
    __device__ __forceinline__ void mid(Acc&, const Unit&, int, int, int, int) const {}
    __device__ __forceinline__ void operator()(const Acc& acc, const Unit& u, int wr, int wc, int fr, int fq) const {
        const int row0 = u.pm * BM + wr * 64 + fr; bf16_t* base = (u.pn < 2) ? KN : V; const int c0 = 256 * (u.pn & 1) + 32 * wc + 8 * fq;
#pragma unroll
        for (int ai = 0; ai < 2; ++ai)
#pragma unroll
            for (int m = 0; m < 4; ++m) { const int row = row0 + ai * HALF + m * 16;
                const f32x4 s0 = *(const f32x4*)(SSQ + (size_t)row * 16 + 8);
                const float rs = __builtin_amdgcn_rsqf(((s0[0] + s0[1]) + (s0[2] + s0[3])) * (1.0f / KVL) + RMS_EPS);
#pragma unroll
                for (int bj = 0; bj < 2; ++bj) *(u32x4*)(base + (size_t)row * 512 + c0 + 128 * bj) = pack8(acc[ai][bj][m][0] * rs, acc[ai][bj][m][1] * rs);
                asm volatile("" ::: "memory"); }
    }
};
struct EpiGluF {
    static constexpr bool AFTER_DRAIN = false, HAS_MID = false;
    const bf16_t* YG; bf16_t* AY; const float* bias;
    __device__ __forceinline__ void mid(Acc&, const Unit&, int, int, int, int) const {}
    __device__ __forceinline__ void operator()(const Acc& acc, const Unit& u, int wr, int wc, int fr, int fq) const {
        const int row0 = u.pm * BM + wr * 64 + fr;
#pragma unroll
        for (int bj = 0; bj < 2; ++bj) { const int c = 256 * u.pn + 128 * bj + 32 * wc + 8 * fq; const f32x4 b0 = *(const f32x4*)(bias + c), b1 = *(const f32x4*)(bias + c + 4);
#pragma unroll
            for (int ai = 0; ai < 2; ++ai)
#pragma unroll
                for (int m = 0; m < 4; ++m) { const int row = row0 + ai * HALF + m * 16; const u32x4 yw = *(const u32x4*)(YG + (size_t)row * SW + c);
                    const f32x4 y0 = bf4_to_f32((u32x2){yw.x, yw.y}), y1 = bf4_to_f32((u32x2){yw.z, yw.w});
                    *(u32x4*)(AY + (size_t)row * DM + 512 + c) = pack8(y0 * fsig4(acc[ai][bj][m][0] + b0), y1 * fsig4(acc[ai][bj][m][1] + b1)); } }
    }
};
template <int ACT> struct EpiStore {
    static constexpr bool AFTER_DRAIN = false, HAS_MID = false;
    bf16_t* O; int ldc;
    __device__ __forceinline__ void mid(Acc&, const Unit&, int, int, int, int) const {}
    __device__ __forceinline__ void operator()(const Acc& acc, const Unit& u, int wr, int wc, int fr, int fq) const {
        const int row0 = u.pm * BM + wr * 64 + fr, c0 = 256 * u.pn + 32 * wc + 8 * fq;
#pragma unroll
        for (int ai = 0; ai < 2; ++ai)
#pragma unroll
            for (int m = 0; m < 4; ++m) { bf16_t* rowp = O + (size_t)(row0 + ai * HALF + m * 16) * ldc + c0;
#pragma unroll
                for (int bj = 0; bj < 2; ++bj) { f32x4 v0 = acc[ai][bj][m][0], v1 = acc[ai][bj][m][1];
                    if (ACT == 1) { const f32x4 z = {0.f, 0.f, 0.f, 0.f}; v0 = __builtin_elementwise_max(v0, z); v1 = __builtin_elementwise_max(v1, z); v0 = v0 * v0; v1 = v1 * v1; }
                    *(u32x4*)(rowp + bj * HALF) = pack8(v0, v1); } }
    }
};
struct EpiMerge {
    static constexpr bool AFTER_DRAIN = false, HAS_MID = true;
    const bf16_t *GA, *GB; bf16_t* MG;
    __device__ __forceinline__ void mid(Acc& acc, const Unit& u, int wr, int wc, int fr, int fq) const {
        const int row0 = u.pm * BM + wr * 64 + fr, c0 = 256 * u.pn + 32 * wc + 8 * fq;
#pragma unroll
        for (int ai = 0; ai < 2; ++ai)
#pragma unroll
            for (int m = 0; m < 4; ++m) { const size_t off = (size_t)(row0 + ai * HALF + m * 16) * DM + c0;
#pragma unroll
                for (int bj = 0; bj < 2; ++bj) { const u32x4 a = *(const u32x4*)(GA + off + bj * HALF), b = *(const u32x4*)(GB + off + bj * HALF);
                    const f32x4 a0 = bf4_to_f32((u32x2){a.x, a.y}), a1 = bf4_to_f32((u32x2){a.z, a.w}), b0 = bf4_to_f32((u32x2){b.x, b.y}), b1 = bf4_to_f32((u32x2){b.z, b.w});
                    f32x4 r0, r1;
#pragma unroll
                    for (int j = 0; j < 4; ++j) { r0[j] = a0[j] * __builtin_amdgcn_rcpf(b0[j]); r1[j] = a1[j] * __builtin_amdgcn_rcpf(b1[j]); }
                    acc[ai][bj][m][0] *= r0; acc[ai][bj][m][1] *= r1; } }
    }
    __device__ __forceinline__ void operator()(const Acc& acc, const Unit& u, int wr, int wc, int fr, int fq) const {
        const int row0 = u.pm * BM + wr * 64 + fr, c0 = 256 * u.pn + 32 * wc + 8 * fq;
#pragma unroll
        for (int ai = 0; ai < 2; ++ai)
#pragma unroll
            for (int m = 0; m < 4; ++m) { const size_t off = (size_t)(row0 + ai * HALF + m * 16) * DM + c0;
#pragma unroll
                for (int bj = 0; bj < 2; ++bj) { const u32x4 b = *(const u32x4*)(GB + off + bj * HALF);
                    const f32x4 b0 = bf4_to_f32((u32x2){b.x, b.y}), b1 = bf4_to_f32((u32x2){b.z, b.w});
                    *(u32x4*)(MG + off + bj * HALF) = pack8(acc[ai][bj][m][0] * b0, acc[ai][bj][m][1] * b1); } }
    }
};
template <int MODE> struct EpiPre {
    static constexpr bool AFTER_DRAIN = false, HAS_MID = false;
    float* out; const float* x; const float* ST0; const float* g; const float* b; const bf16_t* PP; const float* bias;
    __device__ __forceinline__ void mid(Acc&, const Unit&, int, int, int, int) const {}
    __device__ __forceinline__ void operator()(const Acc& acc, const Unit& u, int wr, int wc, int fr, int fq) const {
        const int row0 = u.pm * BM + wr * 64 + fr, c0 = 256 * u.pn + 32 * wc + 4 * fq;
#pragma unroll
        for (int ai = 0; ai < 2; ++ai)
#pragma unroll
            for (int m = 0; m < 4; ++m) { const int row = row0 + ai * HALF + m * 16; const size_t off = (size_t)row * DM + c0;
                f32x2 st = {0.f, 0.f}; if (MODE == 0) st = *(const f32x2*)(ST0 + 2 * (size_t)row);
#pragma unroll
                for (int bj = 0; bj < 2; ++bj)
#pragma unroll
                    for (int n = 0; n < 2; ++n) { const int cc = bj * HALF + n * 16; f32x4 r;
                        if (MODE == 0) { const f32x4 xv = *(const f32x4*)(x + off + cc), gg = *(const f32x4*)(g + c0 + cc), bb = *(const f32x4*)(b + c0 + cc); r = ALPHA * ((xv - st.x) * st.y * gg + bb) + acc[ai][bj][m][n]; }
                        else if (MODE == 1) r = ALPHA * *(const f32x4*)(out + off + cc) + acc[ai][bj][m][n];
                        else { const f32x4 pp = bf4_to_f32(*(const u32x2*)(PP + off + cc)), bi = *(const f32x4*)(bias + c0 + cc); r = ALPHA * *(const f32x4*)(out + off + cc) + fsig4(acc[ai][bj][m][n] + bi) * pp; }
                        *(f32x4*)(out + off + cc) = r; }
                asm volatile("" ::: "memory"); }
    }
};

template <class Epi, class Sched, bool ALIGN_EPI>
__device__ __forceinline__ void gemm_phase(PG8_LAS unsigned char* lds, const Gemm g, const Sched& S, const Epi& E, const int wid) {
    const int lane = (int)__builtin_amdgcn_mbcnt_hi(~0u, __builtin_amdgcn_mbcnt_lo(~0u, 0u)), tid = wid * 64 + lane, wr = wid >> 2, wc = wid & 3, fr = lane & 15, fq = lane >> 4;
    int K = g.K, lda = g.lda; asm volatile("" : "+s"(K), "+s"(lda));
    const int nt = K / BK;
    unsigned voffA[2], voffB[2];
#pragma unroll
    for (int i = 0; i < 2; ++i) { int R, C; stage_rc(tid * 16 + i * 8192, R, C); voffA[i] = (unsigned)(R * lda + C) * 2u; voffB[i] = (unsigned)(R * K + C) * 2u; }
    const size_t kstep = (size_t)(BK * 2);
    const size_t hstepA = (size_t)HALF * lda * 2, hstepB = (size_t)HALF * K * 2;
    const size_t tstepA = 2 * hstepA, tstepB = 2 * hstepB;
    const unsigned ldsw = (unsigned)wid * 1024u;
    const int aoff = lds_byte(wr * 64 + fr, fq * 8), boff = lds_byte(wc * 32 + fr, fq * 8);
#define PG8_SA(b, h) (((b) * 2 + (h)) * HTB)
#define PG8_SB(b, h) ((4 + (b) * 2 + (h)) * HTB)
#define PG8_STAGE(bufoff, gbase, voff) do { _Pragma("unroll") for (int _i = 0; _i < 2; ++_i) \
        __builtin_amdgcn_global_load_lds((const unsigned*)((const char*)(gbase) + (voff)[_i]), (PG8_LAS unsigned*)(lds + (bufoff) + ldsw + _i * 8192), 16, 0, 0); } while (0)
#define PG8_LDA(dst, b, h) do { _Pragma("unroll") for (int m = 0; m < 4; ++m) _Pragma("unroll") for (int k = 0; k < 2; ++k) dst[m][k] = *(const PG8_LAS bf16x8*)(lds + PG8_SA(b, h) + aoff + m * 2048 + k * 1024); } while (0)
#define PG8_LDB(dst, b, h) do { _Pragma("unroll") for (int n = 0; n < 2; ++n) _Pragma("unroll") for (int k = 0; k < 2; ++k) dst[n][k] = *(const PG8_LAS bf16x8*)(lds + PG8_SB(b, h) + boff + n * 2048 + k * 1024); } while (0)
#define PG8_MMA(ai, bj, At, Bt) do { __builtin_amdgcn_s_setprio(1); _Pragma("unroll") for (int m = 0; m < 4; ++m) _Pragma("unroll") for (int n = 0; n < 2; ++n) _Pragma("unroll") for (int k = 0; k < 2; ++k) \
        acc[ai][bj][m][n] = __builtin_amdgcn_mfma_f32_16x16x32_bf16(Bt[n][k], At[m][k], acc[ai][bj][m][n], 0, 0, 0); __builtin_amdgcn_s_setprio(0); } while (0)
#define PG8_WAIT_V(n) asm volatile("s_waitcnt vmcnt(" #n ")" ::: "memory")
#define PG8_WAIT_L(n) asm volatile("s_waitcnt lgkmcnt(" #n ")" ::: "memory")
#define PG8_BAR __builtin_amdgcn_s_barrier()
#define PG8_SCHED __builtin_amdgcn_sched_barrier(0)
    Unit cur, nxt; int ui = 0;
    if (!S.next(0, cur)) return;
    Acc acc;
#pragma unroll
    for (int a = 0; a < 2; ++a)
#pragma unroll
        for (int b = 0; b < 2; ++b)
#pragma unroll
            for (int m = 0; m < 4; ++m)
#pragma unroll
                for (int n = 0; n < 2; ++n) acc[a][b][m][n] = (f32x4){0.f, 0.f, 0.f, 0.f};
    bf16x8 At[4][2], B0[2][2], B1[2][2];
    const char* cA = (const char*)g.A + (size_t)cur.pm * tstepA; const char* cB = (const char*)g.Bt + (size_t)cur.pn * tstepB;
    PG8_STAGE(PG8_SB(0, 0), cB, voffB); PG8_STAGE(PG8_SB(0, 1), cB + hstepB, voffB); PG8_STAGE(PG8_SA(0, 0), cA, voffA); PG8_STAGE(PG8_SA(0, 1), cA + hstepA, voffA);
    if (wr == 1) PG8_BAR;
    PG8_WAIT_V(2); PG8_BAR;
    PG8_STAGE(PG8_SB(1, 0), cB + kstep, voffB); PG8_STAGE(PG8_SA(1, 0), cA + kstep, voffA); PG8_STAGE(PG8_SB(1, 1), cB + hstepB + kstep, voffB);
    PG8_WAIT_V(6); PG8_BAR;
    for (;;) {
        const bool has_next = S.next(ui + 1, nxt);
        const char* nA = has_next ? (const char*)g.A + (size_t)nxt.pm * tstepA : cA; const char* nB = has_next ? (const char*)g.Bt + (size_t)nxt.pn * tstepB : cB;
#pragma clang loop unroll(disable)
        for (int t = 0; t < nt; t += 2) {
            const bool last = (t == nt - 2);
            const char* a1 = cA + (size_t)(t + 1) * kstep;
            const char* a2 = last ? nA : cA + (size_t)(t + 2) * kstep; const char* b2 = last ? nB : cB + (size_t)(t + 2) * kstep;
            const char* a3 = a2 + kstep; const char* b3 = b2 + kstep;
            if constexpr (Epi::HAS_MID) { if (t == g.tmid) { int l2 = (int)__builtin_amdgcn_mbcnt_hi(~0u, __builtin_amdgcn_mbcnt_lo(~0u, 0u)); asm volatile("" : "+v"(l2)); E.mid(acc, cur, wr, wc, l2 & 15, l2 >> 4); } }
            PG8_LDB(B0, 0, 0); PG8_LDB(B1, 0, 1); PG8_SCHED; PG8_LDA(At, 0, 0); PG8_STAGE(PG8_SA(1, 1), a1 + hstepA, voffA);
            PG8_WAIT_V(8); PG8_WAIT_L(0); PG8_BAR; PG8_MMA(0, 0, At, B0); PG8_MMA(0, 1, At, B1); PG8_BAR; PG8_SCHED;
            PG8_LDA(At, 0, 1); PG8_STAGE(PG8_SB(0, 0), b2, voffB); PG8_STAGE(PG8_SB(0, 1), b2 + hstepB, voffB); PG8_STAGE(PG8_SA(0, 0), a2, voffA);
            PG8_WAIT_V(8); PG8_WAIT_L(0); PG8_BAR; PG8_MMA(1, 0, At, B0); PG8_MMA(1, 1, At, B1); PG8_BAR; PG8_SCHED;
            PG8_LDB(B0, 1, 0); PG8_LDB(B1, 1, 1); PG8_SCHED; PG8_LDA(At, 1, 0); PG8_STAGE(PG8_SA(0, 1), a2 + hstepA, voffA);
            PG8_WAIT_V(8); PG8_WAIT_L(0); PG8_BAR; PG8_MMA(0, 0, At, B0); PG8_MMA(0, 1, At, B1); PG8_BAR; PG8_SCHED;
            PG8_LDA(At, 1, 1); PG8_STAGE(PG8_SB(1, 0), b3, voffB); PG8_STAGE(PG8_SB(1, 1), b3 + hstepB, voffB); PG8_STAGE(PG8_SA(1, 0), a3, voffA);
            PG8_WAIT_V(8); PG8_WAIT_L(0); PG8_BAR; PG8_MMA(1, 0, At, B0); PG8_MMA(1, 1, At, B1); PG8_BAR; PG8_SCHED;
        }
        if constexpr (ALIGN_EPI) { if (wr == 0) PG8_BAR; }
        if constexpr (!Epi::AFTER_DRAIN) { int l2 = (int)__builtin_amdgcn_mbcnt_hi(~0u, __builtin_amdgcn_mbcnt_lo(~0u, 0u)); asm volatile("" : "+v"(l2));
            E(acc, cur, wr, wc, l2 & 15, l2 >> 4); }
        if (!has_next) break;
#pragma unroll
        for (int a = 0; a < 2; ++a)
#pragma unroll
            for (int b = 0; b < 2; ++b)
#pragma unroll
                for (int m = 0; m < 4; ++m)
#pragma unroll
                    for (int n = 0; n < 2; ++n) acc[a][b][m][n] = (f32x4){0.f, 0.f, 0.f, 0.f};
        cur = nxt; cA = nA; cB = nB; ++ui;
        if constexpr (ALIGN_EPI) { if (wr == 1) PG8_BAR; }
    }
    PG8_WAIT_V(0);
    if constexpr (!ALIGN_EPI) { if (wr == 0) PG8_BAR; }
    PG8_BAR;
    if constexpr (Epi::AFTER_DRAIN) { E.fused(acc, cur, wr, wc, fr, fq, lds, wid, lane); }
#undef PG8_SA
#undef PG8_SB
#undef PG8_STAGE
#undef PG8_LDA
#undef PG8_LDB
#undef PG8_MMA
#undef PG8_WAIT_V
#undef PG8_WAIT_L
#undef PG8_BAR
#undef PG8_SCHED
}
}

constexpr int NWAVES = 8;
constexpr int RING_OFF = 0, RING_BYTES = 131072;
constexpr int LDSCTL_OFF = RING_BYTES, MISC_OFF = LDSCTL_OFF + 320;
constexpr int LDS_BYTES = 147456;
#define GAS __attribute__((address_space(1)))
#define LAS __attribute__((address_space(3)))
typedef unsigned v4u __attribute__((ext_vector_type(4)));
typedef GAS unsigned gu32;
#define RLX_AGENT __ATOMIC_RELAXED, __HIP_MEMORY_SCOPE_AGENT
#define LDS_WAIT() asm volatile("s_waitcnt lgkmcnt(0)" ::: "memory")
#define VM_WAIT() asm volatile("s_waitcnt vmcnt(0)" ::: "memory")
constexpr int CW_TMO = 0, CW_CODE = 1, CW_BAR = 4096;

#define XB_TMO      128
#define XB_XCNT(j)  (256  + 64 * (j))
#define XB_XSUB(j)  (1280 + 64 * (j))
#define XB_XGEN(j)  (2304 + 64 * (j))
#define XB_TOP      3328
#define XB_TOPGEN   3392
#define XCD_BAR_WORDS 3456
#define XB_SPIN_CAP (1u << 18)
__device__ __forceinline__ unsigned xb_ld(unsigned* p)              { return __hip_atomic_load(p, __ATOMIC_RELAXED, __HIP_MEMORY_SCOPE_AGENT); }
__device__ __forceinline__ unsigned xb_add(unsigned* p, unsigned v) { return __hip_atomic_fetch_add(p, v, __ATOMIC_RELAXED, __HIP_MEMORY_SCOPE_AGENT); }
__device__ __forceinline__ unsigned xb_xcc_id() { return (unsigned)__builtin_amdgcn_s_getreg((3 << 11) | 20) & 0xFu; }
#define XB_SPIN(cond, bar) do { unsigned _sp = 0; while (cond) { __builtin_amdgcn_s_sleep(1); \
    if ((++_sp & 255u) == 0u) { if (xb_ld(&(bar)[XB_TMO])) break; if (_sp > XB_SPIN_CAP) { atomicAdd(&(bar)[XB_TMO], 1u); break; } } } } while (0)
struct XcdBarrier { unsigned* bar; unsigned x; volatile LAS unsigned* st; };
__device__ __forceinline__ XcdBarrier xcd_barrier_post(unsigned* bar, volatile LAS unsigned* st) {
    XcdBarrier b; b.bar = bar; b.x = xb_xcc_id(); b.st = st;
    if (threadIdx.x == 0) (void)xb_add(&bar[XB_XCNT(b.x)], 1u);
    return b;
}
__device__ __forceinline__ void xcd_barrier_complete(unsigned* bar, unsigned x, unsigned& nloc, unsigned& nx) {
    const unsigned G = gridDim.x * gridDim.y * gridDim.z;
    unsigned sum, cnt, mine, sp = 0u;
    for (;;) {
        sum = 0u; cnt = 0u; mine = 0u;
#pragma unroll
        for (unsigned j = 0; j < 16; ++j) { const unsigned c = xb_ld(&bar[XB_XCNT(j)]); sum += c; cnt += (c > 0u) ? 1u : 0u; mine = (j == x) ? c : mine; }
        if (sum == G) break;
        __builtin_amdgcn_s_sleep(1);
        if ((++sp & 255u) == 0u) { if (xb_ld(&bar[XB_TMO])) break; if (sp > XB_SPIN_CAP) { atomicAdd(&bar[XB_TMO], 1u); break; } }
    }
    nloc = mine > 0u ? mine : 1u; nx = cnt > 0u ? cnt : 1u;
}
__device__ __forceinline__ void xcd_barrier(const XcdBarrier& b, const int wave) {
    asm volatile("s_waitcnt vmcnt(0)" ::: "memory");
    __syncthreads();
    if (wave == 0 && (int)__builtin_amdgcn_mbcnt_hi(~0u, __builtin_amdgcn_mbcnt_lo(~0u, 0u)) == 0) {
        unsigned* bar = b.bar;
        __builtin_amdgcn_s_waitcnt(0);
        unsigned nloc = b.st[0], nx = b.st[1];
        if (nloc == 0u) { xcd_barrier_complete(bar, b.x, nloc, nx); b.st[0] = nloc; b.st[1] = nx; }
        const unsigned old = xb_add(&bar[XB_XSUB(b.x)], 1u);
        const unsigned gen = old / nloc;
        if (old + 1u == (gen + 1u) * nloc) {
            __builtin_amdgcn_fence(__ATOMIC_RELEASE, "agent");
            asm volatile("s_waitcnt vmcnt(0)" ::: "memory");
            const unsigned og = xb_add(&bar[XB_TOP], 1u);
            const unsigned tg = og / nx;
            if (og + 1u == (tg + 1u) * nx) xb_add(&bar[XB_TOPGEN], 1u);
            else XB_SPIN(xb_ld(&bar[XB_TOPGEN]) == tg, bar);
            __builtin_amdgcn_fence(__ATOMIC_ACQUIRE, "agent");
            xb_add(&bar[XB_XGEN(b.x)], 1u);
            asm volatile("s_waitcnt vmcnt(0)" ::: "memory");
        } else {
            XB_SPIN(xb_ld(&bar[XB_XGEN(b.x)]) == gen, bar);
            __builtin_amdgcn_fence(__ATOMIC_ACQUIRE, "agent");
            asm volatile("s_waitcnt vmcnt(0)" ::: "memory");
        }
    }
    __syncthreads();
}

__device__ __forceinline__ unsigned f2bf_u(float f) { unsigned u = __builtin_bit_cast(unsigned, f); return (u + 0x7fffu + ((u >> 16) & 1u)) >> 16; }
__device__ __forceinline__ unsigned pk2(float lo, float hi) { return f2bf_u(lo) | (f2bf_u(hi) << 16); }
__device__ __forceinline__ int p8(int r) { const int f = r & 31, n = f >> 4, i = f & 15; return (r & ~31) + 8 * (i >> 2) + 4 * n + (i & 3); }
enum { MAP_ID = 0, MAP_P8 = 1, MAP_WIN = 2, MAP_WUQ = 3, MAP_WUKV = 4 };
__device__ __forceinline__ int tr_srccol(int map, int r) {
    switch (map) {
    case MAP_ID: return r;
    case MAP_P8: return p8(r);
    case MAP_WIN:
        if (r < QL) return OFF_CQ + p8(r);
        if (r < QL + ROPE) return OFF_KR + (r - QL);
        if (r < 512) return -1;
        if (r < 768) return OFF_CKV + p8(r - 512);
        if (r < 1280) return OFF_U + p8(r - 768);
        if (r < 2304) return OFF_GA + p8(r - 1280);
        return OFF_GB + p8(r - 2304);
    case MAP_WUQ: return (((r >> 5) % 3) == 2) ? r : p8(r);
    default: { const int c = p8(r), cc = c & 511, h = cc >> 6, d = cc & 63; return 128 * h + d + ((c >= 512) ? 64 : 0); }
    }
}
struct TrDesc { const float* W; int ldw; int Ksrc; bf16_t* WT; int Kdst; int koff; int Ndst; int map; const float* kscale; };
__device__ __forceinline__ void tr_item(const TrDesc& d, LAS float* scr, int item, int lane) {
    const int nblk = d.Ndst / 32, kb = item / nblk, nb = item % nblk, k0 = 64 * kb, n0 = 32 * nb;
    const int sc = tr_srccol(d.map, n0 + (lane & 31));
#pragma unroll 8
    for (int i = 0; i < 32; ++i) { const int kk = 2 * i + (lane >> 5); float v = (sc >= 0) ? d.W[(size_t)(k0 + kk) * d.ldw + sc] : 0.f; if (d.kscale) v *= d.kscale[k0 + kk]; scr[kk * 33 + (lane & 31)] = v; }
    LDS_WAIT(); asm volatile("" ::: "memory");
    const int c = lane & 7;
#pragma unroll
    for (int j = 0; j < 4; ++j) { const int n = (lane >> 3) + 8 * j; const LAS float* s = scr + (8 * c) * 33 + n;
        v4u o; o.x = pk2(s[0 * 33], s[1 * 33]); o.y = pk2(s[2 * 33], s[3 * 33]); o.z = pk2(s[4 * 33], s[5 * 33]); o.w = pk2(s[6 * 33], s[7 * 33]);
        *(GAS v4u*)(d.WT + (size_t)(n0 + n) * d.Kdst + d.koff + k0 + 8 * c) = o; }
    LDS_WAIT(); asm volatile("" ::: "memory");
}

namespace attn {
using bf16x8 = __attribute__((ext_vector_type(8))) short;
using s16x4 = __attribute__((ext_vector_type(4))) short;
using f32x16 = __attribute__((ext_vector_type(16))) float;
using u32x4 = __attribute__((ext_vector_type(4))) unsigned;
constexpr int NW = 8, QBLK = 32, QB = QBLK * NW, KVBLK = 64, NQB = SEQ / QB;
constexpr int KSLOT = 12288, VSLOT = 8192, NSLOT = 3;
constexpr int LDS_K = 0, LDS_V = NSLOT * KSLOT, LDS_WS = LDS_V + NSLOT * VSLOT, LDS_OST = LDS_WS + NW * 256, LDS_BYTES_ATT = LDS_OST + NW * 4096;
typedef __attribute__((address_space(3))) const char* lds_cptr;
typedef __attribute__((address_space(3))) char* lds_ptr;
typedef short v4i16_t __attribute__((ext_vector_type(4)));
__device__ __forceinline__ int crow(int r, int hi) { return (r & 3) + 8 * (r >> 2) + 4 * hi; }
__device__ __forceinline__ void glds16(const void* gsrc, unsigned lds_dst) { unsigned keep;
    asm volatile("s_mov_b32 %0, m0\n\ts_mov_b32 m0, %2\n\ts_nop 0\n\tglobal_load_lds_dwordx4 %1, off\n\ts_mov_b32 m0, %0" : "=&s"(keep) : "v"(gsrc), "s"(lds_dst) : "memory"); }
__device__ __forceinline__ void glds16s(const char* sbase, unsigned voff, unsigned lds_dst) { unsigned keep;
    asm volatile("s_nop 4\n\ts_mov_b32 %0, m0\n\ts_mov_b32 m0, %3\n\ts_nop 0\n\tglobal_load_lds_dwordx4 %1, %2\n\ts_mov_b32 m0, %0" : "=&s"(keep) : "v"(voff), "s"(sbase), "s"(lds_dst) : "memory"); }
__device__ __forceinline__ unsigned cvtpk(float lo, float hi) { typedef float f2 __attribute__((ext_vector_type(2))); typedef __bf16 b2 __attribute__((ext_vector_type(2))); f2 v = {lo, hi}; b2 b = __builtin_convertvector(v, b2); return __builtin_bit_cast(unsigned, b); }
__device__ __forceinline__ s16x4 vtr(lds_cptr p) { return __builtin_bit_cast(s16x4, __builtin_amdgcn_ds_read_tr16_b64_v4i16((__attribute__((address_space(3))) v4i16_t*)p)); }
#define MX3(a, b, c) __builtin_fmaxf(__builtin_fmaxf((a), (b)), (c))
__device__ __forceinline__ float rowmax(const f32x16& p0, const f32x16& p1) {
    float a = MX3(p0[0], p0[1], p1[0]), b = MX3(p0[2], p0[3], p1[1]); a = MX3(a, p1[2], p1[3]);
#pragma unroll
    for (int r = 4; r < 16; r += 4) { a = MX3(a, p0[r], p0[r + 1]); b = MX3(b, p0[r + 2], p0[r + 3]); a = MX3(a, p1[r], p1[r + 1]); b = MX3(b, p1[r + 2], p1[r + 3]); }
    float m = __builtin_fmaxf(a, b); auto rr = __builtin_amdgcn_permlane32_swap(__float_as_uint(m), __float_as_uint(m), false, false);
    return __builtin_fmaxf(__uint_as_float(rr[0]), __uint_as_float(rr[1])); }
#undef MX3
__device__ __forceinline__ void cmask(f32x16& p0, f32x16& p1, int jb, int qrel, int hi) {
    const int kb = 64 * jb + 4 * hi;
#pragma unroll
    for (int r = 0; r < 16; ++r) { const int kv = kb + (r & 3) + 8 * (r >> 2); if (kv > qrel) p0[r] = -INFINITY; if (kv + 32 > qrel) p1[r] = -INFINITY; } }

template <int THR>
__device__ __forceinline__ void attn_unit(int b, int h, int qb, const bf16_t* __restrict__ Q, const bf16_t* __restrict__ KN, const bf16_t* __restrict__ CQ, const bf16_t* __restrict__ V, bf16_t* __restrict__ O, lds_ptr shm, const int wid) {
    const int lane = (int)__builtin_amdgcn_mbcnt_hi(~0u, __builtin_amdgcn_mbcnt_lo(~0u, 0u)), r32 = lane & 31, hi = lane >> 5;
    const long rowbase = (long)b * SEQ; const int q0 = qb * QB, NT = (q0 + QB) / KVBLK;
    const unsigned lds0 = (unsigned)(uintptr_t)shm;
    __attribute__((address_space(3))) float* wsf = (__attribute__((address_space(3))) float*)(shm + LDS_WS) + wid * 64;
    const char* kbase0 = (const char*)(KN + rowbase * 512 + h * 64 + wid * 8);
    const char* kbase1 = (const char*)(CQ + rowbase * 512 + QL + (wid & 3) * 8);
    const char* vbase = (const char*)(V + (rowbase + 16 * (wid & 3)) * 512 + h * 64 + (wid >> 2) * 32);
    const unsigned koff = (unsigned)lane * 1024u, voff = (unsigned)(lane >> 2) * 1024u + (unsigned)(lane & 3) * 16u;
    const unsigned kdst0 = lds0 + LDS_K + wid * 1024, kdst1 = lds0 + LDS_K + (8 + (wid & 3)) * 1024, vdst = lds0 + LDS_V + wid * 1024;
    const bool w_lo = wid < 4;
#define DMA_TILE(t, s) do { glds16s(kbase0 + (size_t)(t) * (KVBLK * 1024), koff, (unsigned)__builtin_amdgcn_readfirstlane(kdst0 + (s) * KSLOT)); \
        if (w_lo) glds16s(kbase1 + (size_t)(t) * (KVBLK * 1024), koff, (unsigned)__builtin_amdgcn_readfirstlane(kdst1 + (s) * KSLOT)); \
        glds16s(vbase + (size_t)(t) * (KVBLK * 1024), voff, (unsigned)__builtin_amdgcn_readfirstlane(vdst + (s) * VSLOT)); } while (0)
    bf16x8 qr[6];
    { const bf16_t* Qw = Q + (rowbase + q0 + wid * QBLK + r32) * 768 + h * QHD + hi * 8;
#pragma unroll
      for (int d0 = 0; d0 < 6; ++d0) qr[d0] = *reinterpret_cast<const bf16x8*>(Qw + d0 * 16); }
    DMA_TILE(0, 0); DMA_TILE(1, 1);
    float mhat = 0.f, l_reg = 0.f; f32x16 o[2]; o[0] = f32x16{}; o[1] = f32x16{};
    const int qrel = wid * QBLK + r32;
    const lds_cptr kp0 = (lds_cptr)shm + LDS_K + hi * 1024 + r32 * 16;
    const unsigned vb0 = lds0 + LDS_V + ((lane >> 4) & 1) * 32 + (lane & 3) * 8 + (4 * hi + ((lane & 15) >> 2)) * 64;
    int slot = 0;
#pragma clang loop unroll(disable)
    for (int t = 0; t < NT; ++t) {
        if (t + 1 < NT) { if (w_lo) asm volatile("s_waitcnt vmcnt(3)\n\ts_barrier" ::: "memory"); else asm volatile("s_waitcnt vmcnt(2)\n\ts_barrier" ::: "memory"); }
        else asm volatile("s_waitcnt vmcnt(0)\n\ts_barrier" ::: "memory");
        { const int s2 = (slot == 0) ? 2 : slot - 1; if (t + 2 < NT) DMA_TILE(t + 2, s2); }
        f32x16 p0 = f32x16{}, p1 = f32x16{};
        { const lds_cptr kb = kp0 + slot * KSLOT;
#pragma unroll
          for (int d0 = 0; d0 < 6; ++d0) { const bf16x8 k0 = *(const __attribute__((address_space(3))) bf16x8*)(kb + d0 * 2048), k1 = *(const __attribute__((address_space(3))) bf16x8*)(kb + d0 * 2048 + 512);
              p0 = __builtin_amdgcn_mfma_f32_32x32x16_bf16(k0, qr[d0], p0, 0, 0, 0); p1 = __builtin_amdgcn_mfma_f32_32x32x16_bf16(k1, qr[d0], p1, 0, 0, 0);
              if (d0 == 2) __builtin_amdgcn_sched_barrier(0); } }
        { const int jb = t - (NT - 4); if (jb >= 0) cmask(p0, p1, jb, qrel, hi); }
        if (t == 0) { mhat = rowmax(p0, p1);
#pragma unroll
            for (int r = 0; r < 16; ++r) { p0[r] -= mhat; p1[r] -= mhat; } }
        else {
#pragma unroll
            for (int r = 0; r < 16; ++r) { p0[r] -= mhat; p1[r] -= mhat; }
            const float rm = rowmax(p0, p1);
            if (__any(rm > (float)THR)) { const float dl = __builtin_fmaxf(rm, 0.f); mhat += dl;
#pragma unroll
                for (int r = 0; r < 16; ++r) { p0[r] -= dl; p1[r] -= dl; }
                const float f = __builtin_amdgcn_exp2f(-dl); l_reg *= f; if (hi == 0) wsf[r32] = f;
                asm volatile("s_waitcnt lgkmcnt(0)" ::: "memory");
#pragma unroll
                for (int d_ = 0; d_ < 2; ++d_)
#pragma unroll
                    for (int r = 0; r < 16; ++r) o[d_][r] *= wsf[crow(r, hi)];
            }
        }
        float sacc = 0.f;
#pragma unroll
        for (int r = 0; r < 16; ++r) { p0[r] = __builtin_amdgcn_exp2f(p0[r]); p1[r] = __builtin_amdgcn_exp2f(p1[r]); sacc += p0[r] + p1[r]; }
        l_reg += sacc;
        u32x4 pw0, pw1, pw2, pw3;
        pw0 = (u32x4){cvtpk(p0[0], p0[1]), cvtpk(p0[2], p0[3]), cvtpk(p0[4], p0[5]), cvtpk(p0[6], p0[7])};
        pw1 = (u32x4){cvtpk(p0[8], p0[9]), cvtpk(p0[10], p0[11]), cvtpk(p0[12], p0[13]), cvtpk(p0[14], p0[15])};
        pw2 = (u32x4){cvtpk(p1[0], p1[1]), cvtpk(p1[2], p1[3]), cvtpk(p1[4], p1[5]), cvtpk(p1[6], p1[7])};
        pw3 = (u32x4){cvtpk(p1[8], p1[9]), cvtpk(p1[10], p1[11]), cvtpk(p1[12], p1[13]), cvtpk(p1[14], p1[15])};
        { const lds_cptr vp = (lds_cptr)shm + (vb0 - lds0) + slot * VSLOT;
#pragma unroll
          for (int d0 = 0; d0 < 2; ++d0) { s16x4 lo[4], hh[4];
#pragma unroll
              for (int ks = 0; ks < 4; ++ks) { lo[ks] = vtr(vp + d0 * 4096 + ks * 1024); hh[ks] = vtr(vp + d0 * 4096 + ks * 1024 + 512); }
#define PK(k) (bf16x8){lo[k][0], lo[k][1], lo[k][2], lo[k][3], hh[k][0], hh[k][1], hh[k][2], hh[k][3]}
              o[d0] = __builtin_amdgcn_mfma_f32_32x32x16_bf16(__builtin_bit_cast(bf16x8, pw0), PK(0), o[d0], 0, 0, 0);
              o[d0] = __builtin_amdgcn_mfma_f32_32x32x16_bf16(__builtin_bit_cast(bf16x8, pw1), PK(1), o[d0], 0, 0, 0);
              o[d0] = __builtin_amdgcn_mfma_f32_32x32x16_bf16(__builtin_bit_cast(bf16x8, pw2), PK(2), o[d0], 0, 0, 0);
              o[d0] = __builtin_amdgcn_mfma_f32_32x32x16_bf16(__builtin_bit_cast(bf16x8, pw3), PK(3), o[d0], 0, 0, 0);
#undef PK
              __builtin_amdgcn_sched_barrier(0);
          } }
        slot = (slot == 2) ? 0 : slot + 1;
    }
    { auto rr = __builtin_amdgcn_permlane32_swap(__float_as_uint(l_reg), __float_as_uint(l_reg), false, false); l_reg = __uint_as_float(rr[0]) + __uint_as_float(rr[1]); }
    if (hi == 0) wsf[32 + r32] = l_reg;
    asm volatile("s_waitcnt lgkmcnt(0)" ::: "memory");
    float rli[16];
#pragma unroll
    for (int r = 0; r < 16; ++r) rli[r] = __builtin_amdgcn_rcpf(wsf[32 + crow(r, hi)]);
    bf16_t* Ow = O + (rowbase + q0 + wid * QBLK) * DM + h * VD;
    { __attribute__((address_space(3))) bf16_t* stg = (__attribute__((address_space(3))) bf16_t*)(shm + LDS_OST) + wid * 2048;
#pragma unroll
      for (int r = 0; r < 16; ++r) { const int orow = crow(r, hi);
#pragma unroll
          for (int d0 = 0; d0 < 2; ++d0) stg[orow * 64 + d0 * 32 + r32] = f2bf(o[d0][r] * rli[r]); }
      asm volatile("s_waitcnt lgkmcnt(0)" ::: "memory");
#pragma unroll
      for (int i = 0; i < 4; ++i) { const int row = i * 8 + (lane >> 3), ch = lane & 7; const u32x4 v = *(const __attribute__((address_space(3))) u32x4*)(stg + row * 64 + ch * 8); *(u32x4*)(Ow + (long)row * DM + ch * 8) = v; } }
    asm volatile("s_waitcnt vmcnt(0) lgkmcnt(0)\n\ts_barrier" ::: "memory");
#undef DMA_TILE
}
__device__ __forceinline__ void attn_phase(lds_ptr lds, int vcu, int G, const bf16_t* Q, const bf16_t* KN, const bf16_t* CQ, const bf16_t* V, bf16_t* O, const int wid) {
    for (int v = vcu; v < NB * NH * 4; v += G) {
        const int bh = v >> 2, j = v & 3, b = bh / NH, h = bh % NH;
#pragma clang loop unroll(disable)
        for (int i = 0; i < 4; ++i) { const int qb = (i == 0) ? 15 - j : (i == 1) ? 8 + j : (i == 2) ? 7 - j : j; attn_unit<8>(b, h, qb, Q, KN, CQ, V, O, lds, wid); }
    }
}
}
namespace s5 {
using bf16x8 = __attribute__((ext_vector_type(8))) short;
using f32x16 = __attribute__((ext_vector_type(16))) float;
using u32x4 = __attribute__((ext_vector_type(4))) unsigned;
constexpr size_t TAB_WB = 0;
constexpr size_t TAB_KB = TAB_WB + (size_t)NG * 65536;
constexpr size_t TAB_CB = TAB_KB + (size_t)NG * 131072;
constexpr size_t TAB_AP = TAB_CB + (size_t)NG * 65536;
constexpr size_t TAB_END = TAB_AP + (size_t)NG * SP * 16;
typedef __attribute__((address_space(3))) float* lds_f;
__device__ __forceinline__ int blk_of_row(int i) { return 16 * ((i >> 2) & 1) + (i & 3) + 4 * (i >> 3); }

__device__ __forceinline__ void build_tables(int g, unsigned char* tab, const float* a_re, const float* a_im, const float* log_dt, const float* b_re, const float* b_im,
                                             const float* c_re, const float* c_im, const float* d_skip, lds_f L, int tid) {
    lds_f PWr = L, PWi = L + 17 * 64;
    lds_f BBr = L + 2 * 17 * 64, BBi = BBr + 64 * 16;
    lds_f CCr = BBi + 64 * 16, CCi = CCr + 16 * 64;
    lds_f KT = CCi + 16 * 64;
    if (tid < 64) { const int k = tid;
        const double dt = (double)__expf(log_dt[g]);
        const double lr = (double)fminf(a_re[g * SP + k], -1e-4f), li = (double)a_im[g * SP + k];
        const double mag = exp_small_d(lr * dt); double sn, cs; sincos_d(li * dt, sn, cs);
        const double abr = mag * cs, abi = mag * sn;
        const double den = lr * lr + li * li, nr = abr - 1.0, ni = abi;
        const double fr = (nr * lr + ni * li) / den, fi = (ni * lr - nr * li) / den;
        double pr = 1.0, pi = 0.0;
        for (int t = 0; t <= 16; ++t) { PWr[t * 64 + k] = (float)pr; PWi[t * 64 + k] = (float)pi; const double q = pr * abr - pi * abi; pi = pr * abi + pi * abr; pr = q; }
        double a16r, a16i; { double qr = 1.0, qi = 0.0, br = abr, bi = abi; for (int t = 0; t < 16; ++t) { const double q = qr * br - qi * bi; qi = qr * bi + qi * br; qr = q; } a16r = qr; a16i = qi; }
        double a256r = a16r, a256i = a16i; for (int t = 0; t < 4; ++t) { const double q = a256r * a256r - a256i * a256i; a256i = 2.0 * a256r * a256i; a256r = q; }
        float* ap = (float*)(tab + TAB_AP) + ((size_t)g * SP + k) * 4; ap[0] = (float)a16r; ap[1] = (float)a16i; ap[2] = (float)a256r; ap[3] = (float)a256i;
        for (int n = 0; n < 16; ++n) { const double br = (double)b_re[((size_t)g * SP + k) * SG + n], bi = (double)b_im[((size_t)g * SP + k) * SG + n];
            BBr[k * 16 + n] = (float)(fr * br - fi * bi); BBi[k * 16 + n] = (float)(fr * bi + fi * br); }
        for (int n = 0; n < 16; ++n) { CCr[n * 64 + k] = c_re[((size_t)g * SG + n) * SP + k]; CCi[n * 64 + k] = c_im[((size_t)g * SG + n) * SP + k]; }
    }
    __syncthreads();
    for (int e = tid; e < 4096; e += 512) { const int tau = e >> 8, n = (e >> 4) & 15, n2 = e & 15; float acc = 0.f;
        for (int k = 0; k < 64; ++k) { const float cr = CCr[n * 64 + k], ci = CCi[n * 64 + k], pr = PWr[tau * 64 + k], pi = PWi[tau * 64 + k];
            const float mr = cr * pr - ci * pi, mi = cr * pi + ci * pr; acc += mr * BBr[k * 16 + n2] - mi * BBi[k * 16 + n2]; }
        if (tau == 0 && n == n2) acc += d_skip[g * SG + n];
        KT[e] = acc; }
    __syncthreads();
    { bf16_t* WB = (bf16_t*)(tab + TAB_WB) + (size_t)g * 32768;
      for (int e = tid; e < 32768; e += 512) { const int jj = e & 7, lane = (e >> 3) & 63, s = (e >> 9) & 15, ct = e >> 13; const int cc = 32 * ct + (lane & 31), k = cc & 63, n = 8 * (lane >> 5) + jj;
          const float pr = PWr[(15 - s) * 64 + k], pi = PWi[(15 - s) * 64 + k], br = BBr[k * 16 + n], bi = BBi[k * 16 + n];
          WB[e] = f2bf((cc < 64) ? (pr * br - pi * bi) : (pr * bi + pi * br)); } }
    { bf16_t* KBt = (bf16_t*)(tab + TAB_KB) + (size_t)g * 65536;
      for (int e = tid; e < 65536; e += 512) { const int jj = e & 7, lane = (e >> 3) & 63, ks = (e >> 9) & 15, ct = e >> 13; const int so = 2 * ct + ((lane & 31) >> 4), no = lane & 15, n2 = 8 * (lane >> 5) + jj;
          KBt[e] = f2bf((ks <= so) ? KT[((so - ks) << 8) + (no << 4) + n2] : 0.f); } }
    { bf16_t* CBt = (bf16_t*)(tab + TAB_CB) + (size_t)g * 32768;
      for (int e = tid; e < 32768; e += 512) { const int jj = e & 7, lane = (e >> 3) & 63, ks2 = (e >> 9) & 7, ct = e >> 12; const int so = 2 * ct + ((lane & 31) >> 4), no = lane & 15, cc = 16 * ks2 + 8 * (lane >> 5) + jj, k = cc & 63;
          const float cr = CCr[no * 64 + k], ci = CCi[no * 64 + k], pr = PWr[(so + 1) * 64 + k], pi = PWi[(so + 1) * 64 + k];
          CBt[e] = f2bf((cc < 64) ? (cr * pr - ci * pi) : -(cr * pi + ci * pr)); } }
    __syncthreads();
}

__device__ __forceinline__ void s5_unit(int b, int g, const bf16_t* __restrict__ U2, const unsigned char* __restrict__ tab, bf16_t* __restrict__ YG, __attribute__((address_space(3))) unsigned char* L, const int wid) {
    const int lane = (int)__builtin_amdgcn_mbcnt_hi(~0u, __builtin_amdgcn_mbcnt_lo(~0u, 0u)), j = lane & 31, hh = lane >> 5;
    const bf16_t* ub = U2 + (((size_t)b * NG + g) * SEQ + 512 * wid + 16 * blk_of_row(j)) * 16 + 8 * hh;
    const u32x4* WB = (const u32x4*)(tab + TAB_WB + (size_t)g * 65536) + lane;
    const u32x4* KBt = (const u32x4*)(tab + TAB_KB + (size_t)g * 131072) + lane;
    const u32x4* CBt = (const u32x4*)(tab + TAB_CB + (size_t)g * 65536) + lane;
    const float* ap = (const float*)(tab + TAB_AP) + (size_t)g * SP * 4;
    bf16x8 A[16];
#pragma unroll
    for (int s = 0; s < 16; ++s) A[s] = *(const bf16x8*)(ub + s * 16);
    f32x16 Z[4];
#pragma unroll
    for (int ct = 0; ct < 4; ++ct) { Z[ct] = f32x16{};
#pragma unroll
        for (int s = 0; s < 16; ++s) { const u32x4 w = WB[(ct * 16 + s) * 64]; Z[ct] = __builtin_amdgcn_mfma_f32_32x32x16_bf16(A[s], __builtin_bit_cast(bf16x8, w), Z[ct], 0, 0, 0); } }
    const float4 p0 = *(const float4*)(ap + j * 4), p1 = *(const float4*)(ap + (32 + j) * 4);
    float x0r = 0.f, x0i = 0.f, x1r = 0.f, x1i = 0.f;
#pragma unroll
    for (int r = 0; r < 16; ++r) { const float t0 = p0.x * x0r - p0.y * x0i + Z[0][r], t1 = p0.x * x0i + p0.y * x0r + Z[2][r]; x0r = t0; x0i = t1;
        const float t2 = p1.x * x1r - p1.y * x1i + Z[1][r], t3 = p1.x * x1i + p1.y * x1r + Z[3][r]; x1r = t2; x1i = t3; }
    lds_f EL = (lds_f)L;
    { const int seg = 2 * wid + hh; EL[seg * 128 + j] = x0r; EL[seg * 128 + 32 + j] = x1r; EL[seg * 128 + 64 + j] = x0i; EL[seg * 128 + 96 + j] = x1i; }
    asm volatile("s_waitcnt lgkmcnt(0)" ::: "memory"); __builtin_amdgcn_s_barrier(); asm volatile("" ::: "memory");
    x0r = 0.f; x0i = 0.f; x1r = 0.f; x1i = 0.f;
    { const int seg = 2 * wid + hh;
      for (int q = 0; q < 2 * wid + 1; ++q) { if (q < seg) { const float e0r = EL[q * 128 + j], e1r = EL[q * 128 + 32 + j], e0i = EL[q * 128 + 64 + j], e1i = EL[q * 128 + 96 + j];
              const float t0 = p0.z * x0r - p0.w * x0i + e0r, t1 = p0.z * x0i + p0.w * x0r + e0i; x0r = t0; x0i = t1;
              const float t2 = p1.z * x1r - p1.w * x1i + e1r, t3 = p1.z * x1i + p1.w * x1r + e1i; x1r = t2; x1i = t3; } } }
#pragma unroll
    for (int r = 0; r < 16; ++r) { const float z0 = Z[0][r], z1 = Z[1][r], z2 = Z[2][r], z3 = Z[3][r];
        Z[0][r] = x0r; Z[1][r] = x1r; Z[2][r] = x0i; Z[3][r] = x1i;
        const float t0 = p0.x * x0r - p0.y * x0i + z0, t1 = p0.x * x0i + p0.y * x0r + z2; x0r = t0; x0i = t1;
        const float t2 = p1.x * x1r - p1.y * x1i + z1, t3 = p1.x * x1i + p1.y * x1r + z3; x1r = t2; x1i = t3; }
    __attribute__((address_space(3))) bf16_t* XT = (__attribute__((address_space(3))) bf16_t*)(L + 8192 + wid * 8704);
#pragma unroll
    for (int ct = 0; ct < 4; ++ct)
#pragma unroll
        for (int r = 0; r < 16; ++r) XT[(16 * hh + r) * 136 + 32 * ct + j] = f2bf(Z[ct][r]);
    asm volatile("s_waitcnt lgkmcnt(0)" ::: "memory");
    bf16x8 X[8];
#pragma unroll
    for (int k2 = 0; k2 < 8; ++k2) X[k2] = *(const __attribute__((address_space(3))) bf16x8*)(XT + blk_of_row(j) * 136 + 16 * k2 + 8 * hh);
    bf16_t* yb = YG + ((size_t)b * SEQ + 512 * wid + 256 * hh) * SW + g * SG + (j & 15);
#pragma unroll
    for (int ct = 0; ct < 8; ++ct) { f32x16 acc = f32x16{};
#pragma unroll
        for (int ks = 0; ks < 2 * ct + 2; ++ks) { const u32x4 w = KBt[(ct * 16 + ks) * 64]; acc = __builtin_amdgcn_mfma_f32_32x32x16_bf16(A[ks], __builtin_bit_cast(bf16x8, w), acc, 0, 0, 0); }
#pragma unroll
        for (int k2 = 0; k2 < 8; ++k2) { const u32x4 w = CBt[(ct * 8 + k2) * 64]; acc = __builtin_amdgcn_mfma_f32_32x32x16_bf16(X[k2], __builtin_bit_cast(bf16x8, w), acc, 0, 0, 0); }
        const int so = 2 * ct + (j >> 4);
#pragma unroll
        for (int r = 0; r < 16; ++r) { const float v = acc[r]; const float z = 1.5957691216057308f * (v + 0.044715f * v * v * v);
            yb[(size_t)(16 * r + so) * SW] = f2bf(v * pg8::fsig(z)); } }
    asm volatile("s_waitcnt lgkmcnt(0)" ::: "memory"); __builtin_amdgcn_s_barrier(); asm volatile("" ::: "memory");
}
}
constexpr size_t WS_S5TAB = 41 * MiB;
static_assert(WS_S5TAB + s5::TAB_END <= WS_PB, "s5 tables");
struct Args { const void* in[35]; float* out; unsigned char* ws; int ph_lo, ph_hi, li, pad; };
enum { PH_PRO = 0, PH_IN = 1, PH_QKV = 2, PH_MIX = 3, PH_GLU = 4, PH_MERGE = 5, PH_WO = 6, PH_LN1 = 7, PH_UP = 8, PH_DOWN = 9, PH_LN2 = 10, PH_PLE = 11, PH_LN3 = 12, PH_END = 13 };

__device__ __forceinline__ void ln_rows(int gw, int NGW, int lane, float* io, bf16_t* xn, const float* __restrict__ g, const float* __restrict__ b) {
    typedef float f4 __attribute__((ext_vector_type(4)));
    const f4 g0 = ((const f4*)g)[lane], g1 = ((const f4*)g)[lane + 64], g2 = ((const f4*)g)[lane + 128], g3 = ((const f4*)g)[lane + 192];
    const f4 b0 = ((const f4*)b)[lane], b1 = ((const f4*)b)[lane + 64], b2 = ((const f4*)b)[lane + 128], b3 = ((const f4*)b)[lane + 192];
    for (int m = gw; m < M; m += NGW) {
        GAS f4* xr = (GAS f4*)(io + (size_t)m * DM) + lane;
        f4 v[4]; float s = 0.f;
#pragma unroll
        for (int j = 0; j < 4; ++j) { v[j] = xr[64 * j]; s += (v[j].x + v[j].y) + (v[j].z + v[j].w); }
#pragma unroll
        for (int o = 1; o < 64; o <<= 1) s += __shfl_xor(s, o);
        const float mean = s * (1.f / DM); float s2 = 0.f;
#pragma unroll
        for (int j = 0; j < 4; ++j) { v[j] = v[j] - mean; s2 += (v[j].x * v[j].x + v[j].y * v[j].y) + (v[j].z * v[j].z + v[j].w * v[j].w); }
#pragma unroll
        for (int o = 1; o < 64; o <<= 1) s2 += __shfl_xor(s2, o);
        const float rstd = 1.0f / sqrtf(s2 * (1.f / DM) + LN_EPS);
        v[0] = v[0] * rstd * g0 + b0; v[1] = v[1] * rstd * g1 + b1; v[2] = v[2] * rstd * g2 + b2; v[3] = v[3] * rstd * g3 + b3;
#pragma unroll
        for (int j = 0; j < 4; ++j) xr[64 * j] = v[j];
        if (xn) { GAS unsigned long long* o8 = (GAS unsigned long long*)(xn + (size_t)m * DM) + lane;
#pragma unroll
            for (int j = 0; j < 4; ++j) o8[64 * j] = (unsigned long long)pk2(v[j].x, v[j].y) | ((unsigned long long)pk2(v[j].z, v[j].w) << 32); }
    }
}

__global__ void __launch_bounds__(NWAVES * 64, 2) mk_fwd(Args args) {
    extern __shared__ __attribute__((aligned(16))) unsigned char lds_raw[];
    LAS unsigned char* lds = (LAS unsigned char*)lds_raw;
    volatile LAS unsigned* MISC = (volatile LAS unsigned*)(lds + MISC_OFF);
    const int wave = __builtin_amdgcn_readfirstlane(threadIdx.x >> 6);
#define LANE_ID() ((int)__builtin_amdgcn_mbcnt_hi(~0u, __builtin_amdgcn_mbcnt_lo(~0u, 0u)))
    const int G = gridDim.x, bx = blockIdx.x, vcu = (G % 8 == 0) ? (bx % 8) * (G / 8) + bx / 8 : bx;
    unsigned char* ws = args.ws;
    gu32* ctl = (gu32*)(ws + WS_CTL);
    for (int u = threadIdx.x; u < (LDS_BYTES - LDSCTL_OFF) / 4; u += NWAVES * 64) ((LAS unsigned*)(lds + LDSCTL_OFF))[u] = 0u;
    __syncthreads();
    XcdBarrier bar = xcd_barrier_post((unsigned*)(ctl + CW_BAR) + args.li * XCD_BAR_WORDS, MISC + 8);
    const int lo = args.ph_lo, hi = args.ph_hi;
#ifndef PHMASK
#define PHMASK 0xffff
#endif
#define IN(k) (((PHMASK >> (k)) & 1) && lo <= (k) && (k) < hi)
#define SEAM(k) do { if (IN(k) && IN((k) + 1)) xcd_barrier(bar, wave); } while (0)
    const float* x = (const float*)args.in[0];
    float* out = args.out;
    float* ST0 = (float*)(ws + WS_ST0); float* SSQ = (float*)(ws + WS_SSQ); const float2* RT = (const float2*)(ws + WS_ROPE);
    bf16_t *PB = (bf16_t*)(ws + WS_PB), *XN = (bf16_t*)(ws + WS_XN), *Q = (bf16_t*)(ws + WS_Q), *KN = (bf16_t*)(ws + WS_KN), *V = (bf16_t*)(ws + WS_V), *PP = (bf16_t*)(ws + WS_PP),
           *FF = (bf16_t*)(ws + WS_FF), *GA = (bf16_t*)(ws + WS_GA), *GB = (bf16_t*)(ws + WS_GB), *MG = (bf16_t*)(ws + WS_MG), *AY = (bf16_t*)(ws + WS_AY), *U2 = (bf16_t*)(ws + WS_U2),
           *YG = (bf16_t*)(ws + WS_YG), *CQ = (bf16_t*)(ws + WS_CQ), *CKV = (bf16_t*)(ws + WS_CKV);
    bf16_t *WinT = (bf16_t*)(ws + WS_WIN), *WuqT = (bf16_t*)(ws + WS_WUQ), *WukvT = (bf16_t*)(ws + WS_WUKV), *WgluT = (bf16_t*)(ws + WS_WGLU), *WpleT = (bf16_t*)(ws + WS_WPLE),
           *WbrT = (bf16_t*)(ws + WS_WBR), *WoT = (bf16_t*)(ws + WS_WO), *WupT = (bf16_t*)(ws + WS_WUP), *WdownT = (bf16_t*)(ws + WS_WDOWN), *WpgT = (bf16_t*)(ws + WS_WPG);
    const int gw = vcu * NWAVES + wave, NGW = G * NWAVES;

    if (IN(PH_PRO)) {
        LAS float* scr = (LAS float*)(lds + RING_OFF + wave * 16384);
        const TrDesc descs[11] = {
            {(const float*)args.in[5], INW, DM, WinT, DM, 0, NIN_PAD, MAP_WIN, nullptr},
            {(const float*)args.in[8], NH * QHD, QL, WuqT, QL, 0, NH * QHD, MAP_WUQ, (const float*)args.in[7]},
            {(const float*)args.in[10], NH * 128, KVL, WukvT, KVL, 0, NH * 128, MAP_WUKV, (const float*)args.in[9]},
            {(const float*)args.in[20], SW, SW, WgluT, SW, 0, SW, MAP_P8, nullptr},
            {(const float*)args.in[32], DM, PLE, WpleT, PLE, 0, DM, MAP_P8, nullptr},
            {(const float*)args.in[11], DM, 512, WbrT, DM, 0, DM, MAP_P8, nullptr},
            {(const float*)args.in[22], DM, 512, WbrT, DM, 512, DM, MAP_P8, nullptr},
            {(const float*)args.in[23], DM, DM, WoT, DM, 0, DM, MAP_ID, nullptr},
            {(const float*)args.in[26], DFF, DM, WupT, DM, 0, DFF, MAP_P8, nullptr},
            {(const float*)args.in[27], DM, DFF, WdownT, DFF, 0, DM, MAP_ID, nullptr},
            {(const float*)args.in[30], DM, DM, WpgT, DM, 0, DM, MAP_ID, nullptr}};
        int base = 0;
#pragma unroll
        for (int d = 0; d < 11; ++d) { const int n = (descs[d].Ksrc / 64) * (descs[d].Ndst / 32);
            for (int it = gw; it < base + n; it += NGW) { if (it >= base) tr_item(descs[d], scr, it - base, LANE_ID()); }
            base += n; }
        { typedef float f4 __attribute__((ext_vector_type(4))); const int lane = LANE_ID(); const float* lg = (const float*)args.in[3]; const float* lb = (const float*)args.in[4];
          const f4 g0 = ((const f4*)lg)[lane], g1 = ((const f4*)lg)[lane + 64], g2 = ((const f4*)lg)[lane + 128], g3 = ((const f4*)lg)[lane + 192];
          const f4 b0 = ((const f4*)lb)[lane], b1 = ((const f4*)lb)[lane + 64], b2 = ((const f4*)lb)[lane + 128], b3 = ((const f4*)lb)[lane + 192];
          for (int m = gw; m < M; m += NGW) {
              const GAS f4* xr = (const GAS f4*)(x + (size_t)m * DM) + lane; f4 v[4]; float s = 0.f;
#pragma unroll
              for (int j = 0; j < 4; ++j) { v[j] = xr[64 * j]; s += (v[j].x + v[j].y) + (v[j].z + v[j].w); }
#pragma unroll
              for (int o = 1; o < 64; o <<= 1) s += __shfl_xor(s, o);
              const float mean = s * (1.f / DM); float s2 = 0.f;
#pragma unroll
              for (int j = 0; j < 4; ++j) { v[j] = v[j] - mean; s2 += (v[j].x * v[j].x + v[j].y * v[j].y) + (v[j].z * v[j].z + v[j].w * v[j].w); }
#pragma unroll
              for (int o = 1; o < 64; o <<= 1) s2 += __shfl_xor(s2, o);
              const float rstd = 1.0f / sqrtf(s2 * (1.f / DM) + LN_EPS);
              if (lane == 0) { ST0[2 * (size_t)m] = mean; ST0[2 * (size_t)m + 1] = rstd; }
              v[0] = v[0] * rstd * g0 + b0; v[1] = v[1] * rstd * g1 + b1; v[2] = v[2] * rstd * g2 + b2; v[3] = v[3] * rstd * g3 + b3;
              GAS unsigned long long* o8 = (GAS unsigned long long*)(XN + (size_t)m * DM) + lane;
#pragma unroll
              for (int j = 0; j < 4; ++j) o8[64 * j] = (unsigned long long)pk2(v[j].x, v[j].y) | ((unsigned long long)pk2(v[j].z, v[j].w) << 32); }
          { const f4* pin = (const f4*)args.in[1]; unsigned long long* po = (unsigned long long*)PB;
            for (size_t i = (size_t)gw * 64 + lane; i < (size_t)M * PLE / 4; i += (size_t)NGW * 64) { const f4 t = pin[i]; po[i] = (unsigned long long)pk2(t.x, t.y) | ((unsigned long long)pk2(t.z, t.w) << 32); } }
          { const int* pos = (const int*)args.in[2]; float2* rt = (float2*)(ws + WS_ROPE);
            for (int i = gw * 64 + lane; i < M * 16; i += NGW * 64) { const float ang = (float)pos[i >> 4] * c_inv_freq[i & 15]; double sn, cs; sincos_d((double)ang, sn, cs); rt[i] = make_float2((float)cs, (float)sn); } }
        }
        __syncthreads();
        for (int g = vcu; g < NG; g += G) s5::build_tables(g, ws + WS_S5TAB, (const float*)args.in[12], (const float*)args.in[13], (const float*)args.in[14], (const float*)args.in[15], (const float*)args.in[16],
                                                          (const float*)args.in[17], (const float*)args.in[18], (const float*)args.in[19], (s5::lds_f)(lds + RING_OFF), wave * 64 + LANE_ID());
    }
    SEAM(PH_PRO);
    if (IN(PH_IN)) {
        pg8::Gemm g{XN, WinT, DM, NIN_PAD, DM, -1}; pg8::StaticOrder S; S.init(M, NIN_PAD, G, bx);
        pg8::EpiIn E{CQ, CKV, U2, GA, GB, SSQ, RT, (const float*)args.in[6]};
        pg8::gemm_phase<pg8::EpiIn, pg8::StaticOrder, true>(lds + RING_OFF, g, S, E, wave);
    }
    SEAM(PH_IN);
    if (IN(PH_QKV)) {
#ifndef NO_G2
        { pg8::Gemm g{CQ, WuqT, 512, NH * QHD, QL, -1}; pg8::StaticOrder S; S.init(M, NH * QHD, G, bx);
          pg8::EpiQ E{Q, SSQ, RT}; pg8::gemm_phase<pg8::EpiQ, pg8::StaticOrder, true>(lds + RING_OFF, g, S, E, wave); }
#endif
#ifndef NO_G3
        { pg8::Gemm g{CKV, WukvT, KVL, NH * 128, KVL, -1}; pg8::StaticOrder S; S.init(M, NH * 128, G, bx);
          pg8::EpiKV E{KN, V, SSQ}; pg8::gemm_phase<pg8::EpiKV, pg8::StaticOrder, true>(lds + RING_OFF, g, S, E, wave); }
#endif
    }
    SEAM(PH_QKV);
    if (IN(PH_MIX)) {
#ifndef NO_ATT
        attn::attn_phase((attn::lds_ptr)(lds + RING_OFF), vcu, G, Q, KN, CQ, V, AY, wave);
#endif
#ifndef NO_S5
        for (int v = vcu; v < NB * NG; v += G) s5::s5_unit(v / NG, v % NG, U2, ws + WS_S5TAB, YG, lds + RING_OFF, wave);
#endif
    }
    SEAM(PH_MIX);
    if (IN(PH_GLU)) {
        { pg8::Gemm g{YG, WgluT, SW, SW, SW, -1}; pg8::StaticOrder S; S.init(M, SW, G, bx);
          pg8::EpiGluF E{YG, AY, (const float*)args.in[21]}; pg8::gemm_phase<pg8::EpiGluF, pg8::StaticOrder, true>(lds + RING_OFF, g, S, E, wave); }
        { pg8::Gemm g{PB, WpleT, PLE, DM, PLE, -1}; pg8::StaticOrder S; S.init(M, DM, G, bx);
          pg8::EpiStore<0> E{PP, DM}; pg8::gemm_phase<pg8::EpiStore<0>, pg8::StaticOrder, true>(lds + RING_OFF, g, S, E, wave); }
    }
    SEAM(PH_GLU);
    if (IN(PH_MERGE)) {
        pg8::Gemm g{AY, WbrT, DM, DM, DM, 8}; pg8::StaticOrder S; S.init(M, DM, G, bx);
        pg8::EpiMerge E{GA, GB, MG}; pg8::gemm_phase<pg8::EpiMerge, pg8::StaticOrder, true>(lds + RING_OFF, g, S, E, wave);
    }
    SEAM(PH_MERGE);
    if (IN(PH_WO)) {
        pg8::Gemm g{MG, WoT, DM, DM, DM, -1}; pg8::StaticOrder S; S.init(M, DM, G, bx);
        pg8::EpiPre<0> E{out, x, ST0, (const float*)args.in[3], (const float*)args.in[4], nullptr, nullptr};
        pg8::gemm_phase<pg8::EpiPre<0>, pg8::StaticOrder, true>(lds + RING_OFF, g, S, E, wave);
    }
    SEAM(PH_WO);
    if (IN(PH_LN1)) ln_rows(gw, NGW, LANE_ID(), out, XN, (const float*)args.in[24], (const float*)args.in[25]);
    SEAM(PH_LN1);
    if (IN(PH_UP)) {
        pg8::Gemm g{XN, WupT, DM, DFF, DM, -1}; pg8::StaticOrder S; S.init(M, DFF, G, bx);
        pg8::EpiStore<1> E{FF, DFF}; pg8::gemm_phase<pg8::EpiStore<1>, pg8::StaticOrder, true>(lds + RING_OFF, g, S, E, wave);
    }
    SEAM(PH_UP);
    if (IN(PH_DOWN)) {
        pg8::Gemm g{FF, WdownT, DFF, DM, DFF, -1}; pg8::StaticOrder S; S.init(M, DM, G, bx);
        pg8::EpiPre<1> E{out, nullptr, nullptr, nullptr, nullptr, nullptr, nullptr};
        pg8::gemm_phase<pg8::EpiPre<1>, pg8::StaticOrder, true>(lds + RING_OFF, g, S, E, wave);
    }
    SEAM(PH_DOWN);
    if (IN(PH_LN2)) ln_rows(gw, NGW, LANE_ID(), out, XN, (const float*)args.in[28], (const float*)args.in[29]);
    SEAM(PH_LN2);
    if (IN(PH_PLE)) {
        pg8::Gemm g{XN, WpgT, DM, DM, DM, -1}; pg8::StaticOrder S; S.init(M, DM, G, bx);
        pg8::EpiPre<2> E{out, nullptr, nullptr, nullptr, nullptr, PP, (const float*)args.in[31]};
        pg8::gemm_phase<pg8::EpiPre<2>, pg8::StaticOrder, true>(lds + RING_OFF, g, S, E, wave);
    }
    SEAM(PH_PLE);
    if (IN(PH_LN3)) ln_rows(gw, NGW, LANE_ID(), out, nullptr, (const float*)args.in[33], (const float*)args.in[34]);
#undef IN
#undef SEAM
}

template <class Epi> static void run_gemm(hipStream_t st, const bf16_t* A, int lda, const float* W, int ldw, const float* wscale, int N, int K, Epi e) {
    hipLaunchKernelGGL(ref_gemm<Epi>, dim3((N + 63) / 64, M / 64), dim3(256), 0, st, A, lda, W, ldw, wscale, N, K, e);
}
static int g_grid = 0;
static void launch_mk(hipStream_t st, Args a, int lo, int hi, int li) {
    a.ph_lo = lo; a.ph_hi = hi; a.li = li; a.pad = 0;
    hipLaunchKernelGGL(mk_fwd, dim3(g_grid), dim3(NWAVES * 64), LDS_BYTES, st, a);
    const hipError_t le = hipPeekAtLastError();
    if (le != hipSuccess) fprintf(stderr, "kernel_launch: mk_fwd launch failed: %s\n", hipGetErrorName(le));
}
extern "C" void kernel_launch(void* const* d_in, const int* in_sizes, int n_in, void* d_out, int out_size, void* d_ws, size_t ws_size, hipStream_t stream) {
    if (n_in != 35 || in_sizes[0] != M * DM || out_size != M * DM || ws_size < WS_END) { fprintf(stderr, "kernel_launch: unexpected shapes (n_in %d, in0 %d, out %d, ws %zu)\n", n_in, n_in > 0 ? in_sizes[0] : -1, out_size, ws_size); return; }
    if (g_grid == 0) {
        int dev = 0, cus = 0, per_cu = 0;
        if (hipGetDevice(&dev) != hipSuccess || hipDeviceGetAttribute(&cus, hipDeviceAttributeMultiprocessorCount, dev) != hipSuccess) { fprintf(stderr, "kernel_launch: device query failed\n"); g_grid = -1; return; }
        if (hipFuncSetAttribute((const void*)mk_fwd, hipFuncAttributeMaxDynamicSharedMemorySize, LDS_BYTES) != hipSuccess) { fprintf(stderr, "kernel_launch: hipFuncSetAttribute failed\n"); g_grid = -1; return; }
        if (hipOccupancyMaxActiveBlocksPerMultiprocessor(&per_cu, (const void*)mk_fwd, NWAVES * 64, LDS_BYTES) != hipSuccess || per_cu < 1) { fprintf(stderr, "kernel_launch: occupancy query says %d blocks per CU\n", per_cu); g_grid = -1; (void)hipGetLastError(); return; }
        (void)hipGetLastError();
        g_grid = cus;
        if (g_grid % 8 != 0 || g_grid <= 0) { fprintf(stderr, "kernel_launch: unexpected CU count %d\n", cus); }
    }
    if (g_grid < 0) return;
    const float* x = (const float*)d_in[0]; const float* p = (const float*)d_in[1]; const int* pos = (const int*)d_in[2];
    const float *ln_in_g = (const float*)d_in[3], *ln_in_b = (const float*)d_in[4], *a_re = (const float*)d_in[12],
                *a_im = (const float*)d_in[13], *log_dt = (const float*)d_in[14], *b_re = (const float*)d_in[15], *b_im = (const float*)d_in[16], *c_re = (const float*)d_in[17],
                *c_im = (const float*)d_in[18], *d_skip = (const float*)d_in[19];
    unsigned char* ws = (unsigned char*)d_ws; float* out = (float*)d_out;
    float* ST0 = (float*)(ws + WS_ST0); float2* RT = (float2*)(ws + WS_ROPE);
    bf16_t *PB = (bf16_t*)(ws + WS_PB), *XN = (bf16_t*)(ws + WS_XN), *Q = (bf16_t*)(ws + WS_Q), *KN = (bf16_t*)(ws + WS_KN), *V = (bf16_t*)(ws + WS_V),
           *AY = (bf16_t*)(ws + WS_AY), *U2 = (bf16_t*)(ws + WS_U2), *YG = (bf16_t*)(ws + WS_YG), *CQ = (bf16_t*)(ws + WS_CQ);
    (void)hipMemsetAsync(ws + WS_CTL, 0, CTL_ZERO_BYTES, stream);
    Args a{};
    for (int i = 0; i < 35; ++i) a.in[i] = d_in[i];
    a.out = out; a.ws = ws;
    launch_mk(stream, a, PH_PRO, PH_END, 0);
    (void)x; (void)p; (void)pos; (void)ln_in_g; (void)ln_in_b; (void)ST0; (void)RT; (void)PB; (void)XN; (void)Q; (void)KN; (void)V; (void)AY; (void)U2; (void)YG; (void)CQ; (void)a_re; (void)a_im; (void)log_dt; (void)b_re; (void)b_im; (void)c_re; (void)c_im; (void)d_skip;
}
```
